# Optimizing an MI355X kernel written in HIP

```python
import math
import jax, jax.numpy as jnp
from jax import lax
import numpy as np

D_MODEL = 1024
BATCH = 4
SEQ = 8192
DEPTH = 2

HEAD_DIM = 64
Q_BLOCK = 128
MIX_W = 512
N_BRANCH = 4
SWA_HEADS = 8
SWA_KV_HEADS = 2
SWA_WINDOW = 128
CONV_K = 3
NSA_HEADS = 8
NSA_KV_HEADS = 2
CMP_BLOCK = 32
CMP_STRIDE = 16
CMP_HIDDEN = 256
SEL_BLOCK = 64
SEL_TOPK = 16
NSA_WINDOW = 512
RET_HEADS = 4
RET_QK_DIM = 64
RET_V_DIM = 128
RET_CHUNK = 128
ROPE_BASE = 10000.0
D_FF = 2816
EPS = 1e-6

SWA_Q = SWA_HEADS * HEAD_DIM
SWA_KV = SWA_KV_HEADS * HEAD_DIM
NSA_Q = NSA_HEADS * HEAD_DIM
NSA_KV = NSA_KV_HEADS * HEAD_DIM
RET_QK = RET_HEADS * RET_QK_DIM
RET_V = RET_HEADS * RET_V_DIM
IN_WIDTHS = (
    SWA_Q, SWA_KV, SWA_KV,
    MIX_W, MIX_W, MIX_W,
    NSA_Q, NSA_KV, NSA_KV, NSA_KV, NSA_KV, NSA_KV, NSA_KV,
    NSA_HEADS * 3,
    RET_QK, RET_QK, RET_V, RET_V,
    N_BRANCH * D_MODEL,
)
IN_TOTAL = sum(IN_WIDTHS)
SPLIT_POINTS = tuple(int(v) for v in np.cumsum(IN_WIDTHS)[:-1])

kernel_name = "hybrid_parallel_gated_swa_conv_nsa_retention"


def rms_norm(x, g):
    xf = x.astype(jnp.float32)
    y = xf * lax.rsqrt(jnp.mean(xf * xf, axis=-1, keepdims=True) + EPS)
    return (y * g.astype(jnp.float32)).astype(x.dtype)


def heads(t, n):
    b, s, _ = t.shape
    return t.reshape(b, s, n, -1).transpose(0, 2, 1, 3)


def merge_heads(t):
    b, n, s, d = t.shape
    return t.transpose(0, 2, 1, 3).reshape(b, s, n * d)


def swiglu(x, w_gate, w_up, w_down):
    return (jax.nn.silu(x @ w_gate) * (x @ w_up)) @ w_down


def masked_softmax(s, mask, sink=None):
    s = jnp.where(mask, s.astype(jnp.float32), -jnp.inf)
    m = jnp.max(s, axis=-1, keepdims=True)
    if sink is not None:
        m = jnp.maximum(m, sink)
    m = jnp.where(jnp.isfinite(m), m, 0.0)
    p = jnp.exp(s - m)
    denom = jnp.sum(p, axis=-1, keepdims=True)
    if sink is not None:
        denom = denom + jnp.exp(sink - m)
    return p / jnp.maximum(denom, 1e-30)


def banded_attention(q, k, v, window, sink=None):
    b, h, t, d = q.shape
    g = k.shape[1]
    r = h // g
    n_blk = t // Q_BLOCK
    pad = window
    span = pad + Q_BLOCK
    kp = jnp.pad(k, ((0, 0), (0, 0), (pad, 0), (0, 0)))
    vp = jnp.pad(v, ((0, 0), (0, 0), (pad, 0), (0, 0)))
    qb = q.reshape(b, g, r, n_blk, Q_BLOCK, d).transpose(3, 0, 1, 2, 4, 5)
    scale = d ** -0.5

    def one_block(args):
        qi, i = args
        start = i * Q_BLOCK
        ki = lax.dynamic_slice_in_dim(kp, start, span, axis=2)
        vi = lax.dynamic_slice_in_dim(vp, start, span, axis=2)
        qpos = start + jnp.arange(Q_BLOCK)
        kpos = start - pad + jnp.arange(span)
        diff = qpos[:, None] - kpos[None, :]
        mask = (kpos[None, :] >= 0) & (diff >= 0) & (diff < window)
        s = jnp.einsum('bgrqd,bgkd->bgrqk', qi, ki) * scale
        p = masked_softmax(s, mask, sink)
        return jnp.einsum('bgrqk,bgkd->bgrqd', p.astype(vi.dtype), vi)

    out = lax.map(one_block, (qb, jnp.arange(n_blk)))
    return out.transpose(1, 2, 3, 0, 4, 5).reshape(b, h, t, d)


def swa_sink_mixer(q, k, v, q_gain, k_gain, sinks):
    q = rms_norm(heads(q, SWA_HEADS), q_gain)
    k = rms_norm(heads(k, SWA_KV_HEADS), k_gain)
    v = heads(v, SWA_KV_HEADS)
    sink = sinks.astype(jnp.float32).reshape(1, SWA_KV_HEADS, SWA_HEADS // SWA_KV_HEADS, 1, 1)
    return merge_heads(banded_attention(q, k, v, SWA_WINDOW, sink))


def short_conv_mixer(x_in, gate_b, gate_c, conv_w):
    z = gate_c * x_in
    y = lax.conv_general_dilated(z, conv_w.astype(z.dtype), window_strides=(1,),
                                 padding=((CONV_K - 1, 0),),
                                 dimension_numbers=('NWC', 'WIO', 'NWC'),
                                 feature_group_count=z.shape[-1])
    return gate_b * y


def nsa_mixer(q, kc, vc, ks, vs, kw, vw, gate_logits, q_gain, k_gain,
              pos_k, pos_v, wk1, wk2, wv1, wv2):
    b, t, _ = q.shape
    g = NSA_KV_HEADS
    r = NSA_HEADS // g
    d = HEAD_DIM
    q = rms_norm(heads(q, NSA_HEADS), q_gain)

    kw = rms_norm(heads(kw, g), k_gain[2])
    o_win = banded_attention(q, kw, heads(vw, g), NSA_WINDOW)

    n_cmp = (t - CMP_BLOCK) // CMP_STRIDE + 1
    cmp_start = jnp.arange(n_cmp) * CMP_STRIDE
    cmp_end = cmp_start + CMP_BLOCK - 1
    idx = cmp_start[:, None] + jnp.arange(CMP_BLOCK)[None, :]

    def compress(tok, pe, w1, w2):
        blk = heads(tok, g)[:, :, idx] + pe
        blk = blk.reshape(b, g, n_cmp, CMP_BLOCK * d)
        return jax.nn.gelu(blk @ w1) @ w2

    k_cmp = rms_norm(compress(kc, pos_k, wk1, wk2), k_gain[0])
    v_cmp = compress(vc, pos_v, wv1, wv2)

    n_sel = t // SEL_BLOCK
    sel_k = min(SEL_TOPK, n_sel)
    ks_blk = rms_norm(heads(ks, g), k_gain[1]).reshape(b, g, n_sel, SEL_BLOCK, d)
    vs_blk = heads(vs, g).reshape(b, g, n_sel, SEL_BLOCK, d)
    sel_start = jnp.arange(n_sel) * SEL_BLOCK
    overlap = ((cmp_start[:, None] < sel_start[None, :] + SEL_BLOCK)
               & (cmp_end[:, None] >= sel_start[None, :])).astype(jnp.float32)
    blk_id = jnp.arange(n_sel)
    bi = jnp.arange(b)[:, None, None, None]
    gi = jnp.arange(g)[None, :, None, None]

    n_blk = t // Q_BLOCK
    qb = q.reshape(b, g, r, n_blk, Q_BLOCK, d).transpose(3, 0, 1, 2, 4, 5)
    scale = d ** -0.5

    def one_block(args):
        qi, i = args
        qpos = i * Q_BLOCK + jnp.arange(Q_BLOCK)
        s = jnp.einsum('bgrqd,bgnd->bgrqn', qi, k_cmp) * scale
        p_cmp = masked_softmax(s, cmp_end[None, :] <= qpos[:, None])
        o_cmp = jnp.einsum('bgrqn,bgnd->bgrqd', p_cmp.astype(qi.dtype), v_cmp)
        imp = jnp.einsum('bgrqn,ns->bgqs', p_cmp, overlap)
        cur = qpos // SEL_BLOCK
        causal = blk_id[None, :] <= cur[:, None]
        forced = ((blk_id[None, :] == 0) | (blk_id[None, :] == cur[:, None])
                  | (blk_id[None, :] == cur[:, None] - 1))
        imp = jnp.where(forced, jnp.inf, imp)
        imp = jnp.where(causal, imp, -jnp.inf)
        top_s, top_i = lax.top_k(imp, sel_k)
        valid = top_s > -jnp.inf
        k_g = ks_blk[bi, gi, top_i]
        v_g = vs_blk[bi, gi, top_i]
        tok_pos = top_i[..., None] * SEL_BLOCK + jnp.arange(SEL_BLOCK)
        mask = valid[..., None] & (tok_pos <= qpos[:, None, None])
        mask = mask.reshape(b, g, 1, Q_BLOCK, sel_k * SEL_BLOCK)
        s = jnp.einsum('bgrqd,bgqkld->bgrqkl', qi, k_g) * scale
        s = s.reshape(b, g, r, Q_BLOCK, sel_k * SEL_BLOCK)
        p = masked_softmax(s, mask)
        v_g = v_g.reshape(b, g, Q_BLOCK, sel_k * SEL_BLOCK, d)
        o_sel = jnp.einsum('bgrqm,bgqmd->bgrqd', p.astype(v_g.dtype), v_g)
        return o_cmp, o_sel

    o_cmp, o_sel = lax.map(one_block, (qb, jnp.arange(n_blk)))
    o_cmp = o_cmp.transpose(1, 2, 3, 0, 4, 5).reshape(b, NSA_HEADS, t, d)
    o_sel = o_sel.transpose(1, 2, 3, 0, 4, 5).reshape(b, NSA_HEADS, t, d)
    gates = jax.nn.sigmoid(gate_logits.astype(jnp.float32)).astype(q.dtype)
    gates = gates.reshape(b, t, NSA_HEADS, 3).transpose(0, 2, 1, 3)
    o = gates[..., 0:1] * o_cmp + gates[..., 1:2] * o_sel + gates[..., 2:3] * o_win
    return merge_heads(o)


def rotary(x, pos):
    half = x.shape[-1] // 2
    inv = ROPE_BASE ** (-jnp.arange(half, dtype=jnp.float32) / half)
    ang = pos.astype(jnp.float32)[:, None] * inv[None, :]
    cos = jnp.cos(ang).astype(x.dtype)
    sin = jnp.sin(ang).astype(x.dtype)
    x1, x2 = x[..., :half], x[..., half:]
    return jnp.concatenate([x1 * cos - x2 * sin, x1 * sin + x2 * cos], axis=-1)


def retention_mixer(q, k, v, gate, norm_gain):
    b, t, _ = q.shape
    h, c = RET_HEADS, RET_CHUNK
    nc = t // c
    dt = q.dtype
    pos = jnp.arange(t)
    q = rotary(heads(q, h), pos)
    k = rotary(heads(k, h), pos) * (RET_QK_DIM ** -0.5)
    v = heads(v, h)
    log_gamma = jnp.log(1.0 - 2.0 ** (-5.0 - jnp.arange(h, dtype=jnp.float32)))
    j = jnp.arange(c, dtype=jnp.float32)
    diff = j[:, None] - j[None, :]
    dmask = jnp.where(diff >= 0, jnp.exp(diff * log_gamma[:, None, None]), 0.0)
    qc = q.reshape(b, h, nc, c, RET_QK_DIM)
    kc = k.reshape(b, h, nc, c, RET_QK_DIM)
    vc = v.reshape(b, h, nc, c, RET_V_DIM)
    att = jnp.einsum('bhncd,bhnmd->bhncm', qc, kc) * dmask[:, None].astype(dt)
    o = jnp.einsum('bhncm,bhnme->bhnce', att, vc)
    zeta = jnp.exp((c - 1 - j) * log_gamma[:, None]).astype(dt)
    s_chunk = jnp.einsum('bhnmd,bhnme->nbhde', kc * zeta[:, None, :, None], vc)
    decay_chunk = jnp.exp(c * log_gamma).astype(dt)[None, :, None, None]

    def step(r_prev, s_i):
        return r_prev * decay_chunk + s_i, r_prev

    _, r_before = lax.scan(step, jnp.zeros_like(s_chunk[0]), s_chunk)
    xi = jnp.exp((j + 1.0) * log_gamma[:, None]).astype(dt)
    o = o + jnp.einsum('bhncd,nbhde->bhnce', qc * xi[:, None, :, None], r_before)
    o = o.reshape(b, h, t, RET_V_DIM).astype(jnp.float32)
    mu = jnp.mean(o, axis=-1, keepdims=True)
    var = jnp.mean(jnp.square(o - mu), axis=-1, keepdims=True)
    o = ((o - mu) * lax.rsqrt(var + EPS)).astype(dt)
    o = merge_heads(o) * norm_gain
    return jax.nn.silu(gate) * o


def setup_inputs(seed: int = 0) -> dict:
    key = jax.random.key(seed)
    ks = iter(jax.random.split(key, 40))
    f32 = jnp.float32

    def nrm(shape, scale):
        return jax.random.normal(next(ks), shape, f32) * scale

    def gain(shape):
        return 1.0 + 0.02 * jax.random.normal(next(ks), shape, f32)

    L, D = DEPTH, D_MODEL
    return {
        "x": jax.random.normal(next(ks), (BATCH, SEQ, D), f32),
        "ffn1_norm": gain((L, D)),
        "ffn1_w_gate": nrm((L, D, D_FF), D ** -0.5),
        "ffn1_w_up": nrm((L, D, D_FF), D ** -0.5),
        "ffn1_w_down": nrm((L, D_FF, D), D_FF ** -0.5),
        "mix_norm": gain((L, D)),
        "w_in": nrm((L, D, IN_TOTAL), D ** -0.5),
        "merge_gate_bias": nrm((L, N_BRANCH * D), 0.01),
        "swa_q_gain": gain((L, HEAD_DIM)),
        "swa_k_gain": gain((L, HEAD_DIM)),
        "swa_sinks": nrm((L, SWA_HEADS), 1.0),
        "conv_w": nrm((L, CONV_K, 1, MIX_W), CONV_K ** -0.5),
        "nsa_q_gain": gain((L, HEAD_DIM)),
        "nsa_k_gain": gain((L, 3, HEAD_DIM)),
        "cmp_pos_k": nrm((L, CMP_BLOCK, HEAD_DIM), 0.02),
        "cmp_pos_v": nrm((L, CMP_BLOCK, HEAD_DIM), 0.02),
        "cmp_wk1": nrm((L, CMP_BLOCK * HEAD_DIM, CMP_HIDDEN), (CMP_BLOCK * HEAD_DIM) ** -0.5),
        "cmp_wk2": nrm((L, CMP_HIDDEN, HEAD_DIM), CMP_HIDDEN ** -0.5),
        "cmp_wv1": nrm((L, CMP_BLOCK * HEAD_DIM, CMP_HIDDEN), (CMP_BLOCK * HEAD_DIM) ** -0.5),
        "cmp_wv2": nrm((L, CMP_HIDDEN, HEAD_DIM), CMP_HIDDEN ** -0.5),
        "ret_norm_gain": gain((L, RET_V)),
        "w_branch": nrm((L, N_BRANCH, MIX_W, D), MIX_W ** -0.5),
        "w_out": nrm((L, D, D), D ** -0.5),
        "ffn2_norm": gain((L, D)),
        "ffn2_w_gate": nrm((L, D, D_FF), D ** -0.5),
        "ffn2_w_up": nrm((L, D, D_FF), D ** -0.5),
        "ffn2_w_down": nrm((L, D_FF, D), D_FF ** -0.5),
    }


def reference(x, ffn1_norm, ffn1_w_gate, ffn1_w_up, ffn1_w_down, mix_norm, w_in,
              merge_gate_bias, swa_q_gain, swa_k_gain, swa_sinks, conv_w, nsa_q_gain,
              nsa_k_gain, cmp_pos_k, cmp_pos_v, cmp_wk1, cmp_wk2, cmp_wv1, cmp_wv2,
              ret_norm_gain, w_branch, w_out, ffn2_norm, ffn2_w_gate, ffn2_w_up,
              ffn2_w_down):
    b, t, _ = x.shape
    for l in range(DEPTH):
        x = x + 0.5 * swiglu(rms_norm(x, ffn1_norm[l]), ffn1_w_gate[l], ffn1_w_up[l], ffn1_w_down[l])
        u = rms_norm(x, mix_norm[l])
        (a_q, a_k, a_v, b_x, b_b, b_c,
         c_q, c_kc, c_vc, c_ks, c_vs, c_kw, c_vw, c_g,
         d_q, d_k, d_v, d_g, gate_logits) = jnp.split(u @ w_in[l], SPLIT_POINTS, axis=-1)
        y_a = swa_sink_mixer(a_q, a_k, a_v, swa_q_gain[l], swa_k_gain[l], swa_sinks[l])
        y_b = short_conv_mixer(b_x, b_b, b_c, conv_w[l])
        y_c = nsa_mixer(c_q, c_kc, c_vc, c_ks, c_vs, c_kw, c_vw, c_g, nsa_q_gain[l],
                        nsa_k_gain[l], cmp_pos_k[l], cmp_pos_v[l], cmp_wk1[l], cmp_wk2[l],
                        cmp_wv1[l], cmp_wv2[l])
        y_d = retention_mixer(d_q, d_k, d_v, d_g, ret_norm_gain[l])
        ys = jnp.stack([y_a, y_b, y_c, y_d], axis=2)
        branch = jnp.einsum('btnw,nwd->btnd', ys, w_branch[l])
        gates = jax.nn.sigmoid((gate_logits + merge_gate_bias[l]).astype(jnp.float32))
        gates = gates.astype(x.dtype).reshape(b, t, N_BRANCH, D_MODEL)
        merged = jnp.sum(gates * branch, axis=2)
        x = x + merged @ w_out[l]
        x = x + 0.5 * swiglu(rms_norm(x, ffn2_norm[l]), ffn2_w_gate[l], ffn2_w_up[l], ffn2_w_down[l])
    return x
```

```cpp
#include <hip/hip_runtime.h>
#include <hip/hip_cooperative_groups.h>
#include <stdint.h>
#include <math.h>
#include <cstdio>
namespace cg = cooperative_groups;

typedef unsigned short bf16_t;
typedef short bf16x8 __attribute__((ext_vector_type(8)));
typedef short bf16x4 __attribute__((ext_vector_type(4)));
typedef float f32x4 __attribute__((ext_vector_type(4)));
typedef float f32x16 __attribute__((ext_vector_type(16)));
typedef unsigned u32x4 __attribute__((ext_vector_type(4)));
typedef unsigned u32x2 __attribute__((ext_vector_type(2)));

#define NTHREADS 256
#ifndef LEANV
#define LEANV 0
#endif
#ifndef DBG_MASK
#define DBG_MASK 0
#endif
__device__ __forceinline__ int launder_tid() { int t = threadIdx.x; asm volatile("" : "+v"(t)); return t; }
#define TIDX launder_tid()
__device__ __forceinline__ int wave_id() { return __builtin_amdgcn_readfirstlane(launder_tid() >> 6); }
#define WAVE wave_id()
#define SMEM_BYTES 69632

constexpr int T_SEQ = 8192;
constexpr int MTOK = 32768;
constexpr int DM = 1024;
constexpr int DFF = 2816;
constexpr int LDP = 5248;
constexpr int INTOT = 9240;
constexpr int C_AQ = 0, C_AK = 512, C_AV = 640, C_BX = 768, C_BB = 1280, C_BC = 1792, C_CQ = 2304, C_CKC = 2816,
              C_CVC = 2944, C_CKS = 3072, C_CVS = 3200, C_CKW = 3328, C_CVW = 3456, C_CG = 3584, C_DQ = 3712,
              C_DK = 3968, C_DV = 4224, C_DG = 4736, C_MERGED = 2816;

constexpr size_t OFF_WGU1 = 0;
constexpr size_t OFF_WD1 = OFF_WGU1 + (size_t)5632 * 1024 * 2;
constexpr size_t OFF_WIN = OFF_WD1 + (size_t)1024 * 2816 * 2;
constexpr size_t OFF_WGATE = OFF_WIN + (size_t)LDP * 1024 * 2;
constexpr size_t OFF_WBR = OFF_WGATE + (size_t)4096 * 1024 * 2;
constexpr size_t OFF_WOUT = OFF_WBR + (size_t)4 * 1024 * 512 * 2;
constexpr size_t OFF_WGU2 = OFF_WOUT + (size_t)1024 * 1024 * 2;
constexpr size_t OFF_WD2 = OFF_WGU2 + (size_t)5632 * 1024 * 2;
constexpr size_t OFF_WCK1 = OFF_WD2 + (size_t)1024 * 2816 * 2;
constexpr size_t OFF_WCV1 = OFF_WCK1 + (size_t)256 * 2048 * 2;
constexpr size_t OFF_U = OFF_WCV1 + (size_t)256 * 2048 * 2;
constexpr size_t OFF_P = OFF_U + (size_t)MTOK * 1024 * 2;
constexpr size_t OFF_RT = OFF_P + (size_t)(MTOK + 64) * LDP * 2;
constexpr size_t OFF_CMPH = OFF_RT + (size_t)16 * 64 * 8192 * 2;
constexpr size_t OFF_KCMP = OFF_CMPH + (size_t)2 * 4096 * 256 * 2;
constexpr size_t OFF_VCMP = OFF_KCMP + (size_t)8 * 512 * 64 * 2;
constexpr size_t OFF_ROPE = OFF_VCMP + (size_t)8 * 512 * 64 * 2;
constexpr size_t OFF_CB1 = OFF_ROPE + (size_t)8192 * 32 * 8;
constexpr size_t OFF_BAR = OFF_CB1 + 4096;
constexpr size_t WS_NEED = OFF_BAR + 16384;

struct Params {
  const float* in[27];
  float* out;
  unsigned char* ws;
  double inv_freq[32];
};

enum { I_X = 0, I_F1N, I_F1G, I_F1U, I_F1D, I_MIXN, I_WIN, I_MGB, I_SWAQG, I_SWAKG, I_SINK, I_CONVW, I_NSAQG, I_NSAKG,
       I_POSK, I_POSV, I_WK1, I_WK2, I_WV1, I_WV2, I_RETG, I_WBR, I_WOUT, I_F2N, I_F2G, I_F2U, I_F2D };

__device__ __forceinline__ unsigned short f2bf(float f) {
  unsigned u = __float_as_uint(f);
  u += 0x7fffu + ((u >> 16) & 1u);
  return (unsigned short)(u >> 16);
}
__device__ __forceinline__ float bf2f(unsigned short h) { return __uint_as_float(((unsigned)h) << 16); }
__device__ __forceinline__ unsigned pack2(float lo, float hi) { return (unsigned)f2bf(lo) | ((unsigned)f2bf(hi) << 16); }
__device__ __forceinline__ float sigmoidf_(float x) { return 1.f / (1.f + __expf(-x)); }
__device__ __forceinline__ float siluf_(float x) { return x / (1.f + __expf(-x)); }
__device__ __forceinline__ float gelu_tanh(float x) {
  float u = 0.7978845608028654f * (x + 0.044715f * x * x * x);
  float t = 1.f - 2.f / (1.f + __expf(2.f * u));
  return 0.5f * x * (1.f + t);
}
__device__ __forceinline__ int swz(int row, int chunk) { return row * 128 + (((chunk) ^ ((row >> 1) & 7)) << 4); }

__device__ __forceinline__ void convert_job(const float* src0, const float* src1, int Nsrc, int K, bf16_t* dst, int Ndst, int kind, int coloff, unsigned char* smem, bool pack32 = false, int pack_rows = 1 << 30) {
  const int t = TIDX;
  const int nkb = K >> 6, nrb = Ndst >> 6;
  const int nunits = nkb * nrb;
  bf16_t* tl = (bf16_t*)smem;
  const int n4 = (t & 15) * 4, kr = t >> 4;
  for (int u = blockIdx.x; u < nunits; u += gridDim.x) {
    const int rb = u / nkb, kb = u % nkb;
    __syncthreads();
    const int r = rb * 64 + n4;
    const float* sp = src0; int col;
    if (kind == 0) col = r + coloff;
    else if (kind == 1) { const int sel = (r >> 4) & 1; col = 16 * (r >> 5) + (r & 15); sp = sel ? src1 : src0; }
    else { col = (r < 3608) ? r : ((r < 3712) ? -1 : r - 104); }
    f32x4 v[4];
#pragma unroll
    for (int ps = 0; ps < 4; ++ps) {
      v[ps] = (f32x4){0.f, 0.f, 0.f, 0.f};
      if (col >= 0) v[ps] = *(const f32x4*)(sp + (size_t)(kb * 64 + ps * 16 + kr) * Nsrc + col);
    }
#pragma unroll
    for (int ps = 0; ps < 4; ++ps)
#pragma unroll
      for (int e = 0; e < 4; ++e) tl[(n4 + e) * 66 + ps * 16 + kr] = f2bf(v[ps][e]);
    __syncthreads();
#pragma unroll
    for (int i = 0; i < 2; ++i) {
      const int n = (t >> 3) + 32 * i, c = t & 7;
      const unsigned* lp = (const unsigned*)(tl + n * 66 + c * 8);
      u32x4 o; o.x = lp[0]; o.y = lp[1]; o.z = lp[2]; o.w = lp[3];
      if (!pack32 || rb * 64 + n >= pack_rows) *(u32x4*)(dst + (size_t)(rb * 64 + n) * K + kb * 64 + c * 8) = o;
      else {
        const int nn = rb * 64 + n, rowi = nn & 15, ch = c & 3, phys = ch ^ ((0x1320 >> (((rowi >> 2) & 3) * 4)) & 3);
        *(u32x4*)(dst + ((size_t)(nn >> 4) * (K >> 5) + kb * 2 + (c >> 2)) * 512 + rowi * 32 + phys * 8) = o;
      }
    }
  }
}

__device__ __forceinline__ void phase_convert(const Params& p, int l, unsigned char* smem) {
  unsigned char* ws = p.ws;
  convert_job(p.in[I_F1G] + (size_t)l * DM * DFF, p.in[I_F1U] + (size_t)l * DM * DFF, DFF, DM, (bf16_t*)(ws + OFF_WGU1), 5632, 1, 0, smem, true);
  convert_job(p.in[I_F1D] + (size_t)l * DFF * DM, nullptr, DM, DFF, (bf16_t*)(ws + OFF_WD1), 1024, 0, 0, smem, true);
  convert_job(p.in[I_WIN] + (size_t)l * DM * INTOT, nullptr, INTOT, DM, (bf16_t*)(ws + OFF_WIN), LDP, 2, 0, smem, true, 5120);
  convert_job(p.in[I_WIN] + (size_t)l * DM * INTOT, nullptr, INTOT, DM, (bf16_t*)(ws + OFF_WGATE), 4096, 0, 5144, smem);
  for (int i = 0; i < 4; ++i)
    convert_job(p.in[I_WBR] + ((size_t)l * 4 + i) * 512 * DM, nullptr, DM, 512, (bf16_t*)(ws + OFF_WBR) + (size_t)i * 1024 * 512, 1024, 0, 0, smem);
  convert_job(p.in[I_WOUT] + (size_t)l * DM * DM, nullptr, DM, DM, (bf16_t*)(ws + OFF_WOUT), 1024, 0, 0, smem, true);
  convert_job(p.in[I_F2G] + (size_t)l * DM * DFF, p.in[I_F2U] + (size_t)l * DM * DFF, DFF, DM, (bf16_t*)(ws + OFF_WGU2), 5632, 1, 0, smem, true);
  convert_job(p.in[I_F2D] + (size_t)l * DFF * DM, nullptr, DM, DFF, (bf16_t*)(ws + OFF_WD2), 1024, 0, 0, smem, true);
  convert_job(p.in[I_WK1] + (size_t)l * 2048 * 256, nullptr, 256, 2048, (bf16_t*)(ws + OFF_WCK1), 256, 0, 0, smem);
  convert_job(p.in[I_WV1] + (size_t)l * 2048 * 256, nullptr, 256, 2048, (bf16_t*)(ws + OFF_WCV1), 256, 0, 0, smem);
  if (blockIdx.x < 8) {
    __syncthreads();
    const int kv = blockIdx.x >> 2, jc = blockIdx.x & 3, t = TIDX, j = jc * 64 + (t & 63), kq = t >> 6;
    const float* pe = p.in[kv ? I_POSV : I_POSK] + (size_t)l * 2048 + kq * 512;
    const float* w1 = p.in[kv ? I_WV1 : I_WK1] + (size_t)l * 2048 * 256 + (size_t)kq * 512 * 256 + j;
    float sacc = 0.f;
    for (int k0 = 0; k0 < 512; k0 += 16) {
      float wv[16], pv[16];
#pragma unroll
      for (int u = 0; u < 16; ++u) { wv[u] = w1[(size_t)(k0 + u) * 256]; pv[u] = pe[k0 + u]; }
#pragma unroll
      for (int u = 0; u < 16; ++u) sacc += pv[u] * wv[u];
    }
    float* red = (float*)smem;
    red[kq * 64 + (t & 63)] = sacc;
    __syncthreads();
    if (t < 64) ((float*)(ws + OFF_CB1))[kv * 256 + jc * 64 + t] = ((red[t] + red[64 + t]) + red[128 + t]) + red[192 + t];
  }
  if (l == 0) {
    float2* tab = (float2*)(ws + OFF_ROPE);
    for (int i = blockIdx.x * NTHREADS + TIDX; i < 8192 * 32; i += gridDim.x * NTHREADS) {
      const int pos = i >> 5, f = i & 31;
      double rev = (double)pos * p.inv_freq[f] * 0.15915494309189535;
      rev = rev - floor(rev);
      float fr = (float)rev;
      tab[i] = make_float2(__builtin_amdgcn_cosf(fr), __builtin_amdgcn_sinf(fr));
    }
  }
}

__device__ __forceinline__ void phase_norm(const float* x, const float* gain, bf16_t* dst) {
  const int lane = TIDX & 63;
  const int gw = blockIdx.x * 4 + WAVE, nw = gridDim.x * 4;
  f32x4 g[4];
#pragma unroll
  for (int i = 0; i < 4; ++i) g[i] = *(const f32x4*)(gain + i * 256 + lane * 4);
  for (int row = gw; row < MTOK; row += 2 * nw) {
    const int row2 = row + nw;
    const bool has2 = row2 < MTOK;
    const float* xr = x + (size_t)row * DM; const float* xr2 = x + (size_t)(has2 ? row2 : row) * DM;
    f32x4 v[4], v2[4]; float ss = 0.f, ss2 = 0.f;
#pragma unroll
    for (int i = 0; i < 4; ++i) { v[i] = *(const f32x4*)(xr + i * 256 + lane * 4); v2[i] = *(const f32x4*)(xr2 + i * 256 + lane * 4); }
#pragma unroll
    for (int i = 0; i < 4; ++i) {
      ss += v[i][0] * v[i][0] + v[i][1] * v[i][1] + v[i][2] * v[i][2] + v[i][3] * v[i][3];
      ss2 += v2[i][0] * v2[i][0] + v2[i][1] * v2[i][1] + v2[i][2] * v2[i][2] + v2[i][3] * v2[i][3];
    }
#pragma unroll
    for (int o = 32; o >= 1; o >>= 1) { ss += __shfl_xor(ss, o); ss2 += __shfl_xor(ss2, o); }
    const float rs = rsqrtf(ss * (1.f / 1024.f) + 1e-6f), rs2 = rsqrtf(ss2 * (1.f / 1024.f) + 1e-6f);
#pragma unroll
    for (int i = 0; i < 4; ++i) {
      u32x2 o; o.x = pack2(v[i][0] * rs * g[i][0], v[i][1] * rs * g[i][1]); o.y = pack2(v[i][2] * rs * g[i][2], v[i][3] * rs * g[i][3]);
      *(u32x2*)(dst + (size_t)row * DM + i * 256 + lane * 4) = o;
      if (has2) {
        u32x2 o2; o2.x = pack2(v2[i][0] * rs2 * g[i][0], v2[i][1] * rs2 * g[i][1]); o2.y = pack2(v2[i][2] * rs2 * g[i][2], v2[i][3] * rs2 * g[i][3]);
        *(u32x2*)(dst + (size_t)row2 * DM + i * 256 + lane * 4) = o2;
      }
    }
  }
}

#define LDS_AS __attribute__((address_space(3)))
template <int AMODE, int NI>
__device__ __forceinline__ void gemm_mainloop(f32x4 (&acc)[4][NI], const bf16_t* __restrict__ A, long lda, long lda2,
                                              const bf16_t* __restrict__ B, long ldb, int K, int m0, int n0, unsigned char* smem,
                                              bool pre = false, int nm0 = -1, int nn0 = 0) {
  const int lane = TIDX & 63, w = WAVE, wr = w >> 1, wc = w & 1, fr = lane & 15, fq = lane >> 4;
  const int lr = lane >> 3, ph = lane & 7;
  const bf16_t* ap[4]; const bf16_t* bp[NI];
#pragma unroll
  for (int j = 0; j < 4; ++j) {
    const int row = w * 32 + j * 8 + lr, R = m0 + row, c = ph ^ ((row >> 1) & 7);
    if (AMODE == 0) ap[j] = A + (size_t)R * lda + c * 8;
    else { const int bg = R >> 9, n = R & 511; ap[j] = A + ((size_t)(bg >> 1) * T_SEQ + n * 16) * lda + (bg & 1) * 64 + c * 8; }
  }
#pragma unroll
  for (int j = 0; j < NI; ++j) {
    const int row = w * 8 * NI + j * 8 + lr, c = ph ^ ((row >> 1) & 7);
    bp[j] = B + (size_t)(n0 + row) * ldb + c * 8;
  }
  unsigned char* As = smem; unsigned char* Bs = smem + 32768;
  const int a_l = (w * 32) * 128 + lane * 16, b_l = (w * 8 * NI) * 128 + lane * 16;
  const int nk = K >> 6;
  auto issue = [&](int kt, int buf) {
#pragma unroll
    for (int j = 0; j < 4; ++j)
      __builtin_amdgcn_global_load_lds((const unsigned*)(ap[j] + (size_t)kt * lda2), (LDS_AS unsigned*)(As + buf * 16384 + a_l + j * 1024), 16, 0, 0);
#pragma unroll
    for (int j = 0; j < NI; ++j)
      __builtin_amdgcn_global_load_lds((const unsigned*)(bp[j] + (size_t)kt * 64), (LDS_AS unsigned*)(Bs + buf * 16384 + b_l + j * 1024), 16, 0, 0);
  };
  if (!pre) {
    __syncthreads();
    issue(0, 0);
  }
  for (int kt = 0; kt < nk; ++kt) {
    const int cur = kt & 1;
    __syncthreads();
    const unsigned char* a_s = As + cur * 16384; const unsigned char* b_s = Bs + cur * 16384;
    bf16x8 xf[2][4], wf[2][NI];
#pragma unroll
    for (int ks = 0; ks < 2; ++ks) {
#pragma unroll
      for (int i = 0; i < 4; ++i) xf[ks][i] = *(const bf16x8*)(a_s + swz(wr * 64 + 16 * i + fr, ks * 4 + fq));
#pragma unroll
      for (int i = 0; i < NI; ++i) wf[ks][i] = *(const bf16x8*)(b_s + swz(wc * 16 * NI + 16 * i + fr, ks * 4 + fq));
    }
    if (kt + 1 < nk) issue(kt + 1, cur ^ 1);
    else if (nm0 >= 0) {
      const long da = (long)(nm0 - m0) * lda, db = (long)(nn0 - n0) * ldb;
#pragma unroll
      for (int j = 0; j < 4; ++j)
        __builtin_amdgcn_global_load_lds((const unsigned*)(ap[j] + da), (LDS_AS unsigned*)(As + a_l + j * 1024), 16, 0, 0);
#pragma unroll
      for (int j = 0; j < NI; ++j)
        __builtin_amdgcn_global_load_lds((const unsigned*)(bp[j] + db), (LDS_AS unsigned*)(Bs + b_l + j * 1024), 16, 0, 0);
    }
#pragma unroll
    for (int ks = 0; ks < 2; ++ks)
#pragma unroll
      for (int mi = 0; mi < 4; ++mi)
#pragma unroll
        for (int ni = 0; ni < NI; ++ni) acc[mi][ni] = __builtin_amdgcn_mfma_f32_16x16x32_bf16(wf[ks][ni], xf[ks][mi], acc[mi][ni], 0, 0, 0);
  }
}

template <int NI>
__device__ __forceinline__ void zero_acc(f32x4 (&acc)[4][NI]) {
#pragma unroll
  for (int i = 0; i < 4; ++i)
#pragma unroll
    for (int j = 0; j < NI; ++j) acc[i][j] = (f32x4){0.f, 0.f, 0.f, 0.f};
}
__device__ __forceinline__ int xcd_tile(int r, int nN, int& mt, int& nt) {
  const int G8 = gridDim.x >> 3, x = blockIdx.x & 7, slot = blockIdx.x >> 3;
  const int per = 8 * nN, total = 4 * per, nfull = nN >> 2;
  const int L = r * G8 + slot;
  if (L >= total) return -1;
  const int sbm = L / per, Lin = L - sbm * per;
  int sbn, within;
  if (Lin < 32 * nfull) { sbn = Lin >> 5; within = Lin & 31; }
  else { sbn = nfull; within = Lin - 32 * nfull; }
  mt = 32 * x + 8 * sbm + (within & 7); nt = 4 * sbn + (within >> 3);
  return 1;
}
__device__ __forceinline__ void tile_of(int id, int nN, int& mt, int& nt) {
  const int per = 8 * nN; const int g = id / per, rem = id % per;
  mt = g * 8 + (rem & 7); nt = rem >> 3;
}

__device__ __forceinline__ bool next_valid(int& rr, int nN, int& mt, int& nt) {
  for (;;) { const int st = xcd_tile(rr, nN, mt, nt); ++rr; if (st < 0) return false; if (st > 0) return true; }
}
__device__ __forceinline__ void phase_ffn_up(const bf16_t* U, const bf16_t* Wgu, bf16_t* H, unsigned char* smem) {
  const int lane = TIDX & 63, w = WAVE, wr = w >> 1, wc = w & 1, fr = lane & 15, fq = lane >> 4;
  const int nN = 5632 / 128, ntiles = (MTOK / 128) * nN;
  int rr = 0, mt, nt, mt2 = 0, nt2 = 0;
  bool have = next_valid(rr, nN, mt, nt), pre = false;
  for (; have; mt = mt2, nt = nt2) {
    const bool have2 = next_valid(rr, nN, mt2, nt2);
    f32x4 acc[4][4]; zero_acc(acc);
    gemm_mainloop<0, 4>(acc, U, DM, 64, Wgu, DM, DM, mt * 128, nt * 128, smem, pre, have2 ? mt2 * 128 : -1, nt2 * 128);
    pre = have2; have = have2;
    const int hb = (nt * 128 + wc * 64) >> 1;
#pragma unroll
    for (int mi = 0; mi < 4; ++mi) {
      const int m = mt * 128 + wr * 64 + 16 * mi + fr;
#pragma unroll
      for (int np = 0; np < 2; ++np) {
        const f32x4 g = acc[mi][2 * np], u = acc[mi][2 * np + 1];
        u32x2 o; o.x = pack2(siluf_(g[0]) * u[0], siluf_(g[1]) * u[1]); o.y = pack2(siluf_(g[2]) * u[2], siluf_(g[3]) * u[3]);
        *(u32x2*)(H + (size_t)m * DFF + hb + 16 * np + 4 * fq) = o;
      }
    }
  }
}


__device__ __forceinline__ int swz32(int row, int chunk) { return row * 64 + ((chunk ^ ((0x1320 >> (((row >> 2) & 3) * 4)) & 3)) << 4); }
__device__ __forceinline__ void gemm_wide(f32x4 (&acc)[4][8], const bf16_t* __restrict__ A, long lda, const bf16_t* __restrict__ Bp,
                                          int K, int m0, int n0, unsigned char* smem, bool pre, int nm0, int nn0) {
  const int lane = TIDX & 63, w = WAVE, wr = w >> 1, wc = w & 1, fr = lane & 15, fq = lane >> 4;
  const int lr = lane >> 2, ph = lane & 3;
  const int kb32 = K >> 5;
  const bf16_t* ap[2]; const bf16_t* bp[4];
#pragma unroll
  for (int j = 0; j < 2; ++j) {
    const int row = w * 32 + j * 16 + lr, c = ph ^ ((0x1320 >> (((row >> 2) & 3) * 4)) & 3);
    ap[j] = A + (size_t)(m0 + row) * lda + c * 8;
  }
#pragma unroll
  for (int j = 0; j < 4; ++j) bp[j] = Bp + (size_t)((n0 + w * 64 + j * 16) >> 4) * kb32 * 512 + lane * 8;
  unsigned char* As = smem; unsigned char* Bs = smem + 16384;
  const int a_l = (w * 32) * 64 + lane * 16, b_l = (w * 64) * 64 + lane * 16;
  const int nk = kb32;
  auto issue = [&](int kt, int buf, long da, long db) {
#pragma unroll
    for (int j = 0; j < 2; ++j)
      __builtin_amdgcn_global_load_lds((const unsigned*)(ap[j] + da + (size_t)kt * 32), (LDS_AS unsigned*)(As + buf * 8192 + a_l + j * 1024), 16, 0, 0);
#pragma unroll
    for (int j = 0; j < 4; ++j)
      __builtin_amdgcn_global_load_lds((const unsigned*)(bp[j] + db + (size_t)kt * 512), (LDS_AS unsigned*)(Bs + buf * 16384 + b_l + j * 1024), 16, 0, 0);
  };
  if (!pre) {
    __syncthreads();
    issue(0, 0, 0, 0);
  }
  for (int kt = 0; kt < nk; ++kt) {
    const int cur = kt & 1;
    __syncthreads();
    const unsigned char* a_s = As + cur * 8192; const unsigned char* b_s = Bs + cur * 16384;
    bf16x8 xf[4], wf[8];
#pragma unroll
    for (int i = 0; i < 4; ++i) xf[i] = *(const bf16x8*)(a_s + swz32(wr * 64 + 16 * i + fr, fq));
#pragma unroll
    for (int i = 0; i < 8; ++i) wf[i] = *(const bf16x8*)(b_s + swz32(wc * 128 + 16 * i + fr, fq));
    if (kt + 1 < nk) issue(kt + 1, cur ^ 1, 0, 0);
    else if (nm0 >= 0) issue(0, 0, (long)(nm0 - m0) * lda, (long)((nn0 - n0) >> 4) * kb32 * 512);
#pragma unroll
    for (int mi = 0; mi < 4; ++mi)
#pragma unroll
      for (int ni = 0; ni < 8; ++ni) acc[mi][ni] = __builtin_amdgcn_mfma_f32_16x16x32_bf16(wf[ni], xf[mi], acc[mi][ni], 0, 0, 0);
  }
}

__device__ __forceinline__ void phase_ffn_up_wide(const bf16_t* U, const bf16_t* Wgu, bf16_t* H, unsigned char* smem) {
  const int lane = TIDX & 63, w = WAVE, wr = w >> 1, wc = w & 1, fr = lane & 15, fq = lane >> 4;
  const int nN = 5632 / 256;
  int rr = 0, mt, nt, mt2 = 0, nt2 = 0;
  bool have = next_valid(rr, nN, mt, nt), pre = false;
  for (; have; mt = mt2, nt = nt2) {
    const bool have2 = next_valid(rr, nN, mt2, nt2);
    f32x4 acc[4][8];
#pragma unroll
    for (int i = 0; i < 4; ++i)
#pragma unroll
      for (int j = 0; j < 8; ++j) acc[i][j] = (f32x4){0.f, 0.f, 0.f, 0.f};
    gemm_wide(acc, U, DM, Wgu, DM, mt * 128, nt * 256, smem, pre, have2 ? mt2 * 128 : -1, nt2 * 256);
    pre = have2; have = have2;
    const int hb = (nt * 256 + wc * 128) >> 1;
#pragma unroll
    for (int mi = 0; mi < 4; ++mi) {
      const int m = mt * 128 + wr * 64 + 16 * mi + fr;
#pragma unroll
      for (int np = 0; np < 4; ++np) {
        const f32x4 g = acc[mi][2 * np], u = acc[mi][2 * np + 1];
        u32x2 o; o.x = pack2(siluf_(g[0]) * u[0], siluf_(g[1]) * u[1]); o.y = pack2(siluf_(g[2]) * u[2], siluf_(g[3]) * u[3]);
        *(u32x2*)(H + (size_t)m * DFF + hb + 16 * np + 4 * fq) = o;
      }
    }
  }
}

__device__ __forceinline__ void phase_gemm_resid(const bf16_t* A, long lda, const bf16_t* Bt, int K, const float* xsrc, float* out, float scale, unsigned char* smem) {
  const int lane = TIDX & 63, w = WAVE, wr = w >> 1, wc = w & 1, fr = lane & 15, fq = lane >> 4;
  const int nN = DM / 128, ntiles = (MTOK / 128) * nN;
  int rr = 0, mt, nt, mt2 = 0, nt2 = 0;
  bool have = next_valid(rr, nN, mt, nt), pre = false;
  for (; have; mt = mt2, nt = nt2) {
    const bool have2 = next_valid(rr, nN, mt2, nt2);
    f32x4 acc[4][4]; zero_acc(acc);
    gemm_mainloop<0, 4>(acc, A, lda, 64, Bt, K, K, mt * 128, nt * 128, smem, pre, have2 ? mt2 * 128 : -1, nt2 * 128);
    pre = have2; have = have2;
#pragma unroll
    for (int mi = 0; mi < 4; ++mi) {
      const int m = mt * 128 + wr * 64 + 16 * mi + fr;
#pragma unroll
      for (int ni = 0; ni < 4; ++ni) {
        const size_t o = (size_t)m * DM + nt * 128 + wc * 64 + 16 * ni + 4 * fq;
        f32x4 xv = *(const f32x4*)(xsrc + o);
        xv = xv + acc[mi][ni] * scale;
        *(f32x4*)(out + o) = xv;
      }
    }
  }
}


__device__ __forceinline__ void phase_gemm_resid_wide(const bf16_t* A, long lda, const bf16_t* Bp, int K, const float* xsrc, float* out, float scale, unsigned char* smem) {
  const int lane = TIDX & 63, w = WAVE, wr = w >> 1, wc = w & 1, fr = lane & 15, fq = lane >> 4;
  const int nN = DM / 256;
  int rr = 0, mt, nt, mt2 = 0, nt2 = 0;
  bool have = next_valid(rr, nN, mt, nt), pre = false;
  for (; have; mt = mt2, nt = nt2) {
    const bool have2 = next_valid(rr, nN, mt2, nt2);
    f32x4 acc[4][8];
#pragma unroll
    for (int i = 0; i < 4; ++i)
#pragma unroll
      for (int j = 0; j < 8; ++j) acc[i][j] = (f32x4){0.f, 0.f, 0.f, 0.f};
    gemm_wide(acc, A, lda, Bp, K, mt * 128, nt * 256, smem, pre, have2 ? mt2 * 128 : -1, nt2 * 256);
    pre = have2; have = have2;
#pragma unroll
    for (int mi = 0; mi < 4; ++mi) {
      const int m = mt * 128 + wr * 64 + 16 * mi + fr;
#pragma unroll
      for (int ni = 0; ni < 8; ++ni) {
        const size_t o = (size_t)m * DM + nt * 256 + wc * 128 + 16 * ni + 4 * fq;
        f32x4 xv = *(const f32x4*)(xsrc + o);
        xv = xv + acc[mi][ni] * scale;
        *(f32x4*)(out + o) = xv;
      }
    }
  }
}

template <int NIT, int OFF>
__device__ __forceinline__ void proj_epi(const Params& p, int l, f32x4 (&acc)[4][NIT], int mrow0, int nb, int fr, int fq) {
  bf16_t* P = (bf16_t*)(p.ws + OFF_P);
  const float2* rope = (const float2*)(p.ws + OFF_ROPE);
  const int cidx = nb >> 6;
  int type = 0; const float* gain = nullptr; float scale = 1.f;
  if (cidx < 8) { type = 1; gain = p.in[I_SWAQG] + l * 64; scale = 0.125f * 1.4426950408889634f; }
  else if (cidx < 10) { type = 1; gain = p.in[I_SWAKG] + l * 64; }
  else if (cidx >= 36 && cidx < 44) { type = 1; gain = p.in[I_NSAQG] + l * 64; scale = 0.125f * 1.4426950408889634f; }
  else if (cidx == 48 || cidx == 49) { type = 1; gain = p.in[I_NSAKG] + l * 192 + 64; }
  else if (cidx == 52 || cidx == 53) { type = 1; gain = p.in[I_NSAKG] + l * 192 + 128; }
  else if (cidx >= 58 && cidx < 62) { type = 2; }
  else if (cidx >= 62 && cidx < 66) { type = 2; scale = 0.125f; }
  if (type == 1) {
    f32x4 gv[4];
#pragma unroll
    for (int ni = 0; ni < 4; ++ni) gv[ni] = *(const f32x4*)(gain + 16 * ni + 4 * fq) * scale;
#pragma unroll
    for (int mi = 0; mi < 4; ++mi) {
      float ss = 0.f;
#pragma unroll
      for (int ni = 0; ni < 4; ++ni) { const f32x4 a = acc[mi][OFF + ni]; ss += a[0] * a[0] + a[1] * a[1] + a[2] * a[2] + a[3] * a[3]; }
      ss += __shfl_xor(ss, 16); ss += __shfl_xor(ss, 32);
      const float rs = rsqrtf(ss * (1.f / 64.f) + 1e-6f);
#pragma unroll
      for (int ni = 0; ni < 4; ++ni) acc[mi][OFF + ni] = acc[mi][OFF + ni] * rs * gv[ni];
    }
  } else if (type == 2) {
#pragma unroll
    for (int mi = 0; mi < 4; ++mi) {
      const int m = mrow0 + 16 * mi + fr, pos = m & (T_SEQ - 1);
#pragma unroll
      for (int ni = 0; ni < 2; ++ni) {
        const float2* tp = rope + pos * 32 + 16 * ni + 4 * fq;
#pragma unroll
        for (int r = 0; r < 4; ++r) {
          const float2 cs = tp[r];
          const float x1 = acc[mi][OFF + ni][r], x2 = acc[mi][OFF + ni + 2][r];
          acc[mi][OFF + ni][r] = (x1 * cs.x - x2 * cs.y) * scale;
          acc[mi][OFF + ni + 2][r] = (x1 * cs.y + x2 * cs.x) * scale;
        }
      }
    }
  }
#pragma unroll
  for (int mi = 0; mi < 4; ++mi) {
    const int m = mrow0 + 16 * mi + fr;
#pragma unroll
    for (int ni = 0; ni < 4; ++ni) {
      u32x2 o; o.x = pack2(acc[mi][OFF + ni][0], acc[mi][OFF + ni][1]); o.y = pack2(acc[mi][OFF + ni][2], acc[mi][OFF + ni][3]);
      *(u32x2*)(P + (size_t)m * LDP + nb + 16 * ni + 4 * fq) = o;
    }
  }
}

__device__ __forceinline__ void phase_proj(const Params& p, int l, unsigned char* smem) {
  const int lane = TIDX & 63, w = WAVE, wr = w >> 1, wc = w & 1, fr = lane & 15, fq = lane >> 4;
  const bf16_t* U = (const bf16_t*)(p.ws + OFF_U);
  const bf16_t* W = (const bf16_t*)(p.ws + OFF_WIN);
  {
    const int nN = 20;
    int rr = 0, mt, nt, mt2 = 0, nt2 = 0;
    bool have = next_valid(rr, nN, mt, nt), pre = false;
    for (; have; mt = mt2, nt = nt2) {
      const bool have2 = next_valid(rr, nN, mt2, nt2);
      f32x4 acc[4][8];
#pragma unroll
      for (int i = 0; i < 4; ++i)
#pragma unroll
        for (int j = 0; j < 8; ++j) acc[i][j] = (f32x4){0.f, 0.f, 0.f, 0.f};
      gemm_wide(acc, U, DM, W, DM, mt * 128, nt * 256, smem, pre, have2 ? mt2 * 128 : -1, nt2 * 256);
      pre = have2; have = have2;
      proj_epi<8, 0>(p, l, acc, mt * 128 + wr * 64, nt * 256 + wc * 128, fr, fq);
      proj_epi<8, 4>(p, l, acc, mt * 128 + wr * 64, nt * 256 + wc * 128 + 64, fr, fq);
    }
  }
  {
    const int nN = 1;
    int rr = 0, mt, nt, mt2 = 0, nt2 = 0;
    bool have = next_valid(rr, nN, mt, nt), pre = false;
    for (; have; mt = mt2, nt = nt2) {
      const bool have2 = next_valid(rr, nN, mt2, nt2);
      f32x4 acc[4][4]; zero_acc(acc);
      gemm_mainloop<0, 4>(acc, U, DM, 64, W + (size_t)5120 * DM, DM, DM, mt * 128, 0, smem, pre, have2 ? mt2 * 128 : -1, 0);
      pre = have2; have = have2;
      proj_epi<4, 0>(p, l, acc, mt * 128 + wr * 64, 5120 + wc * 64, fr, fq);
    }
  }
}

__device__ __forceinline__ void compress_gemm1_tile(const Params& p, int id, unsigned char* smem) {
  const int lane = TIDX & 63, w = WAVE, wr = w >> 1, wc = w & 1, fr = lane & 15, fq = lane >> 4;
  const int kv = id >> 6, rem = id & 63, mt = rem >> 1, nt = rem & 1;
  const bf16_t* P = (const bf16_t*)(p.ws + OFF_P);
  const bf16_t* A = P + (kv ? C_CVC : C_CKC);
  const bf16_t* W = (const bf16_t*)(p.ws + (kv ? OFF_WCV1 : OFF_WCK1));
  const float* bias = (const float*)(p.ws + OFF_CB1) + kv * 256;
  bf16_t* H = (bf16_t*)(p.ws + OFF_CMPH) + (size_t)kv * 4096 * 256;
  f32x4 acc[4][4]; zero_acc(acc);
  gemm_mainloop<1, 4>(acc, A, LDP, LDP, W, 2048, 2048, mt * 128, nt * 128, smem);
#pragma unroll
  for (int mi = 0; mi < 4; ++mi) {
    const int m = mt * 128 + wr * 64 + 16 * mi + fr;
#pragma unroll
    for (int ni = 0; ni < 4; ++ni) {
      const int n = nt * 128 + wc * 64 + 16 * ni + 4 * fq;
      const f32x4 bv = *(const f32x4*)(bias + n);
      const f32x4 a = acc[mi][ni] + bv;
      u32x2 o; o.x = pack2(gelu_tanh(a[0]), gelu_tanh(a[1])); o.y = pack2(gelu_tanh(a[2]), gelu_tanh(a[3]));
      *(u32x2*)(H + (size_t)m * 256 + n) = o;
    }
  }
}

__device__ __forceinline__ void phase_merge(const Params& p, int l, unsigned char* smem) {
  const int lane = TIDX & 63, w = WAVE, wr = w >> 1, wc = w & 1, fr = lane & 15, fq = lane >> 4;
  const bf16_t* U = (const bf16_t*)(p.ws + OFF_U);
  bf16_t* P = (bf16_t*)(p.ws + OFF_P);
  const bf16_t* Wg = (const bf16_t*)(p.ws + OFF_WGATE);
  const bf16_t* Wb = (const bf16_t*)(p.ws + OFF_WBR);
  const float* bias = p.in[I_MGB] + (size_t)l * 4096;
  const int nN = DM / 128;
  for (int rr = 0;; ++rr) {
    int mt, nt; const int st = xcd_tile(rr, nN, mt, nt);
    if (st < 0) break;
    if (st == 0) continue;
    const int nb = nt * 128 + wc * 64;
    unsigned mrg[4][4][2];
#pragma unroll
    for (int mi = 0; mi < 4; ++mi)
#pragma unroll
      for (int ni = 0; ni < 4; ++ni) { mrg[mi][ni][0] = 0u; mrg[mi][ni][1] = 0u; }
    for (int i = 0; i < 4; ++i) {
      const int ycol = (i == 0) ? C_AQ : (i == 1) ? C_BB : (i == 2) ? C_CQ : C_DG;
      unsigned sg[4][4][2];
      {
        f32x4 acc[4][4]; zero_acc<4>(acc);
        gemm_mainloop<0, 4>(acc, U, DM, 64, Wg + (size_t)i * 1024 * 1024, DM, DM, mt * 128, nt * 128, smem);
#pragma unroll
        for (int ni = 0; ni < 4; ++ni) {
          const f32x4 bv = *(const f32x4*)(bias + i * 1024 + nb + 16 * ni + 4 * fq);
#pragma unroll
          for (int mi = 0; mi < 4; ++mi) {
            const f32x4 a = acc[mi][ni] + bv;
            sg[mi][ni][0] = pack2(sigmoidf_(a[0]), sigmoidf_(a[1]));
            sg[mi][ni][1] = pack2(sigmoidf_(a[2]), sigmoidf_(a[3]));
          }
        }
      }
      f32x4 acc[4][4]; zero_acc<4>(acc);
      gemm_mainloop<0, 4>(acc, P + ycol, LDP, 64, Wb + (size_t)i * 1024 * 512, 512, 512, mt * 128, nt * 128, smem);
#pragma unroll
      for (int mi = 0; mi < 4; ++mi)
#pragma unroll
        for (int ni = 0; ni < 4; ++ni) {
          f32x4 sv;
          sv[0] = __uint_as_float(sg[mi][ni][0] << 16); sv[1] = __uint_as_float(sg[mi][ni][0] & 0xffff0000u);
          sv[2] = __uint_as_float(sg[mi][ni][1] << 16); sv[3] = __uint_as_float(sg[mi][ni][1] & 0xffff0000u);
          const f32x4 t4 = sv * acc[mi][ni];
          const unsigned m0 = mrg[mi][ni][0], m1 = mrg[mi][ni][1];
          mrg[mi][ni][0] = pack2(__uint_as_float(m0 << 16) + t4[0], __uint_as_float(m0 & 0xffff0000u) + t4[1]);
          mrg[mi][ni][1] = pack2(__uint_as_float(m1 << 16) + t4[2], __uint_as_float(m1 & 0xffff0000u) + t4[3]);
        }
    }
#pragma unroll
    for (int mi = 0; mi < 4; ++mi) {
      const int m = mt * 128 + wr * 64 + 16 * mi + fr;
#pragma unroll
      for (int ni = 0; ni < 4; ++ni) {
        u32x2 o; o.x = mrg[mi][ni][0]; o.y = mrg[mi][ni][1];
        *(u32x2*)(P + (size_t)m * LDP + C_MERGED + nb + 16 * ni + 4 * fq) = o;
      }
    }
  }
}

#define MFMA32(a, b, c) __builtin_amdgcn_mfma_f32_32x32x16_bf16(a, b, c, 0, 0, 0)
constexpr int AL_K = 0;
constexpr int AL_VT = 8192;
constexpr int KVB = 16896;
constexpr int AL_IMP = 33792;
constexpr int AL_SEL = 66816;
constexpr int AL_UNI = 67840;
constexpr int VTS = 68;

union FragU { u32x4 u; bf16x8 b; };
typedef short v4i16_t __attribute__((ext_vector_type(4)));
__device__ __forceinline__ int vtr_lane_off(int lane) {
  const int g = lane >> 4, q = (lane & 15) >> 2, p = lane & 3, h = lane >> 5;
  return (4 * h + q) * 128 + ((4 * (q >> 1) + 2 * (g & 1) + (p >> 1)) << 4) + 8 * (p & 1);
}
__device__ __forceinline__ bf16x8 vtr_frag(const unsigned char* vimg, int loff, int dt, int mt, int s) {
  const unsigned char* a = vimg + ((loff ^ (dt << 6)) + (32 * mt + 16 * s) * 128);
  const v4i16_t lo = __builtin_amdgcn_ds_read_tr16_b64_v4i16((LDS_AS v4i16_t*)a);
  const v4i16_t hi = __builtin_amdgcn_ds_read_tr16_b64_v4i16((LDS_AS v4i16_t*)(a + 8 * 128));
  return (bf16x8){lo[0], lo[1], lo[2], lo[3], hi[0], hi[1], hi[2], hi[3]};
}
struct KVRegs { u32x4 k[2], v[2]; };

__device__ __forceinline__ void kv_load(KVRegs& R, const bf16_t* kbase, const bf16_t* vbase, long stride, int key0, bool want_v) {
  const int t = TIDX, c = t & 7, r0 = t >> 3;
#pragma unroll
  for (int i = 0; i < 2; ++i) {
    const size_t o = (size_t)(key0 + r0 + 32 * i) * stride + c * 8;
    R.k[i] = *(const u32x4*)(kbase + o);
    if (want_v) R.v[i] = *(const u32x4*)(vbase + o);
  }
}
__device__ __forceinline__ void kv_store(const KVRegs& R, unsigned char* smem, bool want_v) {
  const int t = TIDX, c = t & 7, r0 = t >> 3;
#pragma unroll
  for (int i = 0; i < 2; ++i) {
    const int row = r0 + 32 * i;
    *(u32x4*)(smem + AL_K + swz(row, c)) = R.k[i];
    if (want_v) *(u32x4*)(smem + AL_VT + row * 128 + ((c ^ (((row >> 1) & 1) << 2)) << 4)) = R.v[i];
  }
}
template <bool QL>
__device__ __forceinline__ void compute_S(const bf16x8 (&q)[4], int nt, f32x16 (&S)[2], const unsigned char* smem, int lane) {
  const int r = lane & 31, h = lane >> 5;
  const unsigned char* qp = smem + AL_IMP + WAVE * 8192 + nt * 4096 + lane * 16;
#pragma unroll
  for (int mt = 0; mt < 2; ++mt) {
#pragma unroll
    for (int i = 0; i < 16; ++i) S[mt][i] = 0.f;
#pragma unroll
    for (int ks = 0; ks < 4; ++ks) {
      const bf16x8 kf = *(const bf16x8*)(smem + AL_K + swz(32 * mt + r, 2 * ks + h));
      const bf16x8 qf = QL ? *(const bf16x8*)(qp + ks * 1024) : q[ks];
      S[mt] = MFMA32(kf, qf, S[mt]);
    }
  }
}
__device__ __forceinline__ void park_q(const bf16x8 (&q)[2][4], unsigned char* smem, int lane) {
  unsigned char* qp = smem + AL_IMP + WAVE * 8192 + lane * 16;
#pragma unroll
  for (int nt = 0; nt < 2; ++nt)
#pragma unroll
    for (int ks = 0; ks < 4; ++ks) *(bf16x8*)(qp + nt * 4096 + ks * 1024) = q[nt][ks];
}
template <int MODE, bool QL>
__device__ __forceinline__ void attn_tile_online(const bf16x8 (&q)[2][4], f32x16 (&O)[2][2], float (&m)[2], float (&l)[2],
                                                 const unsigned char* smem, const unsigned char* kvb, int kv0, int q0, int lane, unsigned selw, bool needmask) {
  const int r = lane & 31, h = lane >> 5;
  const int vloff = vtr_lane_off(lane);
  bool sel[2]; float negm[2];
#pragma unroll
  for (int nt = 0; nt < 2; ++nt) { sel[nt] = (MODE != 2) || ((selw >> nt) & 1u); negm[nt] = (MODE == 2 && !sel[nt]) ? -1e30f : -m[nt]; }
  f32x16 S[2][2];
#pragma unroll
  for (int nt = 0; nt < 2; ++nt)
#pragma unroll
    for (int mt = 0; mt < 2; ++mt)
#pragma unroll
      for (int i = 0; i < 16; ++i) S[nt][mt][i] = negm[nt];
#pragma unroll
  for (int ks = 0; ks < 4; ++ks)
#pragma unroll
    for (int mt = 0; mt < 2; ++mt) {
      const bf16x8 kf = *(const bf16x8*)(kvb + AL_K + swz(32 * mt + r, 2 * ks + h));
#pragma unroll
      for (int nt = 0; nt < 2; ++nt) S[nt][mt] = MFMA32(kf, q[nt][ks], S[nt][mt]);
    }
  if (needmask) {
#pragma unroll
    for (int nt = 0; nt < 2; ++nt)
#pragma unroll
      for (int mt = 0; mt < 2; ++mt) {
        const int dq = q0 + 32 * nt + r - kv0 - 4 * h - 32 * mt;
#pragma unroll
        for (int i = 0; i < 16; ++i) {
          const int cst = (i & 3) + 8 * (i >> 2);
          bool valid;
          if (MODE == 0) valid = (cst <= dq) && (cst > dq - 128);
          else if (MODE == 1) valid = (cst <= dq) && (cst > dq - 512);
          else valid = (cst <= dq);
          S[nt][mt][i] = valid ? S[nt][mt][i] : -INFINITY;
        }
      }
  }
  float mx[2];
#pragma unroll
  for (int nt = 0; nt < 2; ++nt) {
    mx[nt] = -INFINITY;
#pragma unroll
    for (int mt = 0; mt < 2; ++mt) {
      const float a0 = fmaxf(fmaxf(fmaxf(S[nt][mt][0], S[nt][mt][1]), fmaxf(S[nt][mt][2], S[nt][mt][3])), fmaxf(fmaxf(S[nt][mt][4], S[nt][mt][5]), fmaxf(S[nt][mt][6], S[nt][mt][7])));
      const float a1 = fmaxf(fmaxf(fmaxf(S[nt][mt][8], S[nt][mt][9]), fmaxf(S[nt][mt][10], S[nt][mt][11])), fmaxf(fmaxf(S[nt][mt][12], S[nt][mt][13]), fmaxf(S[nt][mt][14], S[nt][mt][15])));
      mx[nt] = fmaxf(mx[nt], fmaxf(a0, a1));
    }
  }
  mx[0] = fmaxf(mx[0], __shfl_xor(mx[0], 32)); mx[1] = fmaxf(mx[1], __shfl_xor(mx[1], 32));
  if (__builtin_amdgcn_ballot_w64(fmaxf(mx[0], mx[1]) > 8.0f) != 0ull) {
#pragma unroll
    for (int nt = 0; nt < 2; ++nt) {
      const float d = (mx[nt] > 8.0f) ? mx[nt] : 0.f;
      const float alpha = __builtin_amdgcn_exp2f(-d);
      m[nt] += d; l[nt] *= alpha;
#pragma unroll
      for (int dt = 0; dt < 2; ++dt) O[nt][dt] = O[nt][dt] * alpha;
#pragma unroll
      for (int mt = 0; mt < 2; ++mt)
#pragma unroll
        for (int i = 0; i < 16; ++i) S[nt][mt][i] -= d;
    }
  }
#pragma unroll
  for (int nt = 0; nt < 2; ++nt) {
    float lsum = 0.f;
#pragma unroll
    for (int mt = 0; mt < 2; ++mt)
#pragma unroll
      for (int i = 0; i < 16; ++i) { const float pp = __builtin_amdgcn_exp2f(S[nt][mt][i]); S[nt][mt][i] = pp; lsum += pp; }
    l[nt] += lsum;
  }
#pragma unroll
  for (int mt = 0; mt < 2; ++mt)
#pragma unroll
    for (int s = 0; s < 2; ++s) {
      FragU pf[2];
#pragma unroll
      for (int nt = 0; nt < 2; ++nt) {
        pf[nt].u.x = pack2(S[nt][mt][8 * s + 0], S[nt][mt][8 * s + 1]); pf[nt].u.y = pack2(S[nt][mt][8 * s + 2], S[nt][mt][8 * s + 3]);
        pf[nt].u.z = pack2(S[nt][mt][8 * s + 4], S[nt][mt][8 * s + 5]); pf[nt].u.w = pack2(S[nt][mt][8 * s + 6], S[nt][mt][8 * s + 7]);
      }
#pragma unroll
      for (int dt = 0; dt < 2; ++dt) {
        const bf16x8 vf = vtr_frag(kvb + AL_VT, vloff, dt, mt, s);
#pragma unroll
        for (int nt = 0; nt < 2; ++nt) O[nt][dt] = MFMA32(vf, pf[nt].b, O[nt][dt]);
      }
    }
}

__device__ __forceinline__ void load_q(bf16x8 (&q)[2][4], const bf16_t* qbase  , int lane) {
  const int r = lane & 31, h = lane >> 5;
#pragma unroll
  for (int nt = 0; nt < 2; ++nt)
#pragma unroll
    for (int ks = 0; ks < 4; ++ks) q[nt][ks] = *(const bf16x8*)(qbase + (size_t)(32 * nt + r) * LDP + 16 * ks + 8 * h);
}
__device__ __forceinline__ void zero_O(f32x16 (&O)[2][2]) {
#pragma unroll
  for (int a = 0; a < 2; ++a)
#pragma unroll
    for (int b = 0; b < 2; ++b)
#pragma unroll
      for (int i = 0; i < 16; ++i) O[a][b][i] = 0.f;
}

template <int MODE, bool QL>
__device__ __forceinline__ void attn_loop(const bf16x8 (&q)[2][4], f32x16 (&O)[2][2], float (&m)[2], float (&l)[2], unsigned char* smem,
                                          const bf16_t* kbase, const bf16_t* vbase, long stride, int t0, int t1, int q0, int lane) {
  unsigned uni[4] = {0xffffffffu, 0xffffffffu, 0xffffffffu, 0xffffffffu};
  if (MODE == 2) {
    const unsigned* up = (const unsigned*)(smem + AL_UNI);
    uni[0] = up[0]; uni[1] = up[1]; uni[2] = up[2]; uni[3] = up[3];
  }
  auto bit = [&](int t) -> bool {
    const unsigned wv = (t < 32) ? uni[0] : (t < 64) ? uni[1] : (t < 96) ? uni[2] : uni[3];
    return (wv >> (t & 31)) & 1u;
  };
  auto next_tile = [&](int t) -> int { if (MODE == 2) { while (t < t1 && !bit(t)) ++t; } return t; };
  auto run_tile = [&](int cur, const unsigned char* kvb) {
    unsigned selw = 0;
    if (MODE == 2) {
      const unsigned* sm = (const unsigned*)(smem + AL_SEL);
      const int r = lane & 31;
      selw = ((sm[r * 4 + (cur >> 5)] >> (cur & 31)) & 1u) | (((sm[(32 + r) * 4 + (cur >> 5)] >> (cur & 31)) & 1u) << 1);
    }
    const int qt_ = q0 >> 6;
    const bool needmask = (MODE == 0) ? (cur != qt_ - 1) : (MODE == 1) ? (cur == qt_ || cur == qt_ - 8) : (cur == qt_);
    attn_tile_online<MODE, QL>(q, O, m, l, smem, kvb, cur * 64, q0, lane, selw, needmask);
  };
  int nxt = next_tile(t0);
  KVRegs R;
  {
    if (nxt >= t1) return;
    kv_load(R, kbase, vbase, stride, nxt * 64, true);
    __syncthreads();
    kv_store(R, smem, true);
    int cur = nxt, bsel = 0;
    nxt = next_tile(cur + 1);
    if (nxt < t1) kv_load(R, kbase, vbase, stride, nxt * 64, true);
    __syncthreads();
    for (;;) {
      run_tile(cur, smem + bsel * KVB);
      if (nxt >= t1) break;
      kv_store(R, smem + (bsel ^ 1) * KVB, true);
      cur = nxt;
      nxt = next_tile(cur + 1);
      if (nxt < t1) kv_load(R, kbase, vbase, stride, nxt * 64, true);
      __syncthreads();
      bsel ^= 1;
    }
  }
}

template <bool FIRST>
__device__ __forceinline__ void y_accum(bf16_t* ybase_in  , const f32x16 (&O)[2][2], const float (&sc)[2], int lane_in) {
  int lane = lane_in; asm volatile("" : "+v"(lane));
  bf16_t* ybase = ybase_in;
  const int r = lane & 31, h = lane >> 5;
#pragma unroll
  for (int nt = 0; nt < 2; ++nt)
#pragma unroll
    for (int dt = 0; dt < 2; ++dt)
#pragma unroll
      for (int g4 = 0; g4 < 4; ++g4) {
        u32x2* ptr = (u32x2*)(ybase + (size_t)(32 * nt + r) * LDP + 32 * dt + 8 * g4 + 4 * h);
        float v0 = O[nt][dt][4 * g4] * sc[nt], v1 = O[nt][dt][4 * g4 + 1] * sc[nt], v2 = O[nt][dt][4 * g4 + 2] * sc[nt], v3 = O[nt][dt][4 * g4 + 3] * sc[nt];
        if (!FIRST) {
          const u32x2 old = *ptr;
          v0 += __uint_as_float(old.x << 16); v1 += __uint_as_float(old.x & 0xffff0000u);
          v2 += __uint_as_float(old.y << 16); v3 += __uint_as_float(old.y & 0xffff0000u);
        }
        u32x2 o; o.x = pack2(v0, v1); o.y = pack2(v2, v3);
        *ptr = o;
      }
}

__device__ __forceinline__ void swa_unit(const Params& p, int l, int unit, unsigned char* smem) {
  const int lane = TIDX & 63, w = WAVE;
  const int qt = unit & 127, bg = unit >> 7, b = bg >> 1, g = bg & 1, head = g * 4 + w, q0 = qt * 64;
  bf16_t* P = (bf16_t*)(p.ws + OFF_P);
  bf16_t* rowb = P + (size_t)b * T_SEQ * LDP;
  bf16x8 q[2][4];
  load_q(q, rowb + (size_t)q0 * LDP + C_AQ + head * 64, lane);
  f32x16 O[2][2]; zero_O(O);
  float m[2] = {0.f, 0.f}, lsum[2] = {0.f, 0.f};
  const int t0 = (q0 >= 128) ? (q0 - 128) / 64 : 0, t1 = qt + 1;
  attn_loop<0, false>(q, O, m, lsum, smem, rowb + C_AK + g * 64, rowb + C_AV + g * 64, LDP, t0, t1, q0, lane);
  const float sink = p.in[I_SINK][l * 8 + head] * 1.4426950408889634f;
  float sc[2];
#pragma unroll
  for (int nt = 0; nt < 2; ++nt) {
    const float lt = lsum[nt] + __shfl_xor(lsum[nt], 32);
    const float mf = fmaxf(m[nt], sink);
    const float e = __builtin_amdgcn_exp2f(m[nt] - mf);
    const float den = lt * e + __builtin_amdgcn_exp2f(sink - mf);
    sc[nt] = e / fmaxf(den, 1e-30f);
  }
  y_accum<true>(rowb + (size_t)q0 * LDP + C_AQ + head * 64, O, sc, lane);
}

__device__ __forceinline__ int wave_max_i32(int v) {
  v = max(v, __builtin_amdgcn_update_dpp(v, v, 0x111, 0xf, 0xf, false));
  v = max(v, __builtin_amdgcn_update_dpp(v, v, 0x112, 0xf, 0xf, false));
  v = max(v, __builtin_amdgcn_update_dpp(v, v, 0x114, 0xf, 0xf, false));
  v = max(v, __builtin_amdgcn_update_dpp(v, v, 0x118, 0xf, 0xf, false));
  v = max(v, __builtin_amdgcn_update_dpp(v, v, 0x142, 0xa, 0xf, false));
  v = max(v, __builtin_amdgcn_update_dpp(v, v, 0x143, 0xc, 0xf, false));
  return __builtin_amdgcn_readlane(v, 63);
}
__device__ __forceinline__ void nsa_unit(const Params& p, int l, int unit, unsigned char* smem, int ycol = C_CQ) {
  const int lane = TIDX & 63, w = WAVE, r = lane & 31, h = lane >> 5;
  const int qt = 127 - (unit >> 3), bg = unit & 7, b = bg >> 1, g = bg & 1, head = g * 4 + w, q0 = qt * 64, cur = qt;
  bf16_t* P = (bf16_t*)(p.ws + OFF_P);
  bf16_t* rowb = P + (size_t)b * T_SEQ * LDP;
  const bf16_t* kcmp = (const bf16_t*)(p.ws + OFF_KCMP) + (size_t)bg * 512 * 64;
  const bf16_t* vcmp = (const bf16_t*)(p.ws + OFF_VCMP) + (size_t)bg * 512 * 64;
  bf16x8 q[2][4];
  load_q(q, rowb + (size_t)q0 * LDP + C_CQ + head * 64, lane);
  auto gate_of = [&](int i, int nt) -> float { int rr = r; asm volatile("" : "+v"(rr)); return sigmoidf_(bf2f(rowb[(size_t)(q0 + 32 * nt + rr) * LDP + C_CG + head * 3 + i])); };
  bf16_t* ybase = rowb + (size_t)q0 * LDP + ycol + head * 64;

  {
    unsigned* imp = (unsigned*)(smem + AL_IMP);
    for (int i = TIDX; i < 64 * 129; i += NTHREADS) imp[i] = 0u;
    unsigned* sm = (unsigned*)(smem + AL_SEL);
    for (int i = TIDX; i < 64 * 4 + 4; i += NTHREADS) sm[i] = 0u;
  }
  const int nmax = (q0 + 32) >> 4;
  const int nct = (nmax >> 6) + 1;
  const bool do_imp = (cur >= 16);
  float m[2] = {-1e30f, -1e30f}, ls[2] = {0.f, 0.f};
  {
    KVRegs R;
    kv_load(R, kcmp, vcmp, 64, 0, false);
    for (int t = 0; t < nct; ++t) {
      __syncthreads();
      kv_store(R, smem, false);
      __syncthreads();
      if (t + 1 < nct) kv_load(R, kcmp, vcmp, 64, (t + 1) * 64, false);
#pragma unroll
      for (int nt = 0; nt < 2; ++nt) {
        __builtin_amdgcn_sched_barrier(0);
        f32x16 S[2];
        compute_S<false>(q[nt], nt, S, smem, lane);
        __builtin_amdgcn_sched_barrier(0);
        const int tq = q0 + 32 * nt + r;
        float mx = -1e30f;
#pragma unroll
        for (int mt = 0; mt < 2; ++mt)
#pragma unroll
          for (int i = 0; i < 16; ++i) {
            const int dn = tq - 31 - 16 * (t * 64 + 32 * mt + 4 * h);
            const float sv = (16 * ((i & 3) + 8 * (i >> 2)) <= dn) ? S[mt][i] : -1e30f;
            S[mt][i] = sv; mx = fmaxf(mx, sv);
          }
        mx = fmaxf(mx, __shfl_xor(mx, 32));
        const float mnew = fmaxf(m[nt], mx);
        const float alpha = __builtin_amdgcn_exp2f(m[nt] - mnew);
        m[nt] = mnew;
        float s1 = 0.f;
#pragma unroll
        for (int mt = 0; mt < 2; ++mt)
#pragma unroll
          for (int i = 0; i < 16; ++i) s1 += (S[mt][i] > -1e29f) ? __builtin_amdgcn_exp2f(S[mt][i] - mnew) : 0.f;
        ls[nt] = ls[nt] * alpha + s1;
      }
    }
  }
  float rl[2];
#pragma unroll
  for (int nt = 0; nt < 2; ++nt) { const float lt = ls[nt] + __shfl_xor(ls[nt], 32); rl[nt] = 1.f / fmaxf(lt, 1e-30f); }
  {
    f32x16 O[2][2]; zero_O(O);
    KVRegs R;
    kv_load(R, kcmp, vcmp, 64, 0, false);
    for (int t = 0; t < nct; ++t) {
      {
        const int tt = TIDX, c = tt & 7, r0 = tt >> 3;
#pragma unroll
        for (int i = 0; i < 2; ++i) R.v[i] = *(const u32x4*)(vcmp + (size_t)(t * 64 + r0 + 32 * i) * 64 + c * 8);
      }
      __syncthreads();
      kv_store(R, smem, true);
      __syncthreads();
      if (t + 1 < nct) kv_load(R, kcmp, vcmp, 64, (t + 1) * 64, false);
#pragma unroll
      for (int nt = 0; nt < 2; ++nt) {
        const int tq = q0 + 32 * nt + r;
        const int vloff = vtr_lane_off(lane);
        unsigned* imp = (unsigned*)(smem + AL_IMP) + (32 * nt + r) * 129;
#pragma unroll
        for (int mt = 0; mt < 2; ++mt) {
          __builtin_amdgcn_sched_barrier(0);
          f32x16 S;
#pragma unroll
          for (int i = 0; i < 16; ++i) S[i] = 0.f;
#pragma unroll
          for (int ks = 0; ks < 4; ++ks) {
            const bf16x8 kf = *(const bf16x8*)(smem + AL_K + swz(32 * mt + r, 2 * ks + h));
            S = MFMA32(kf, q[nt][ks], S);
          }
          __builtin_amdgcn_sched_barrier(0);
#pragma unroll
          for (int i = 0; i < 16; ++i) {
            const int dn = tq - 31 - 16 * (t * 64 + 32 * mt + 4 * h);
            S[i] = (16 * ((i & 3) + 8 * (i >> 2)) <= dn) ? __builtin_amdgcn_exp2f(S[i] - m[nt]) * rl[nt] : 0.f;
          }
          if (do_imp) {
#pragma unroll
            for (int g4 = 0; g4 < 4; ++g4) {
              const int sb = (t * 64 + 32 * mt + 8 * g4 + 4 * h) >> 2;
              const float s4 = (S[4 * g4] + S[4 * g4 + 1]) + (S[4 * g4 + 2] + S[4 * g4 + 3]);
              atomicAdd(&imp[sb], (unsigned)(s4 * 16777216.f + 0.5f));
              if (sb + 1 < 128) atomicAdd(&imp[sb + 1], (unsigned)(S[4 * g4 + 3] * 16777216.f + 0.5f));
            }
          }
#pragma unroll
          for (int s2 = 0; s2 < 2; ++s2) {
            FragU pf;
            pf.u.x = pack2(S[8 * s2 + 0], S[8 * s2 + 1]); pf.u.y = pack2(S[8 * s2 + 2], S[8 * s2 + 3]);
            pf.u.z = pack2(S[8 * s2 + 4], S[8 * s2 + 5]); pf.u.w = pack2(S[8 * s2 + 6], S[8 * s2 + 7]);
#pragma unroll
            for (int dt = 0; dt < 2; ++dt) O[nt][dt] = MFMA32(vtr_frag(smem + AL_VT, vloff, dt, mt, s2), pf.b, O[nt][dt]);
          }
        }
      }
    }
    float sc[2] = {gate_of(0, 0), gate_of(0, 1)};
    y_accum<true>(ybase, O, sc, lane);
  }
  __syncthreads();
  {
    unsigned* sm = (unsigned*)(smem + AL_SEL);
    unsigned* un = (unsigned*)(smem + AL_UNI);
    const unsigned* imp = (const unsigned*)(smem + AL_IMP);
    for (int qi = 0; qi < 16; qi += 2) {
      unsigned mk[2][4];
      int v0[2], v1[2];
#pragma unroll
      for (int u = 0; u < 2; ++u) {
        const int qq = w * 16 + qi + u;
        mk[u][0] = mk[u][1] = mk[u][2] = mk[u][3] = 0u;
        if (!do_imp) {
          mk[u][0] = (cur >= 31) ? 0xffffffffu : ((1u << (cur + 1)) - 1u);
          v0[u] = v1[u] = -1;
        } else {
          v0[u] = (lane >= 1 && lane <= cur - 2) ? (int)imp[qq * 129 + lane] : -1;
          v1[u] = (lane + 64 <= cur - 2) ? (int)imp[qq * 129 + lane + 64] : -1;
          const int fs[3] = {0, cur - 1, cur};
#pragma unroll
          for (int k = 0; k < 3; ++k) {
            const int sb = fs[k];
            if (sb < 32) mk[u][0] |= 1u << sb; else if (sb < 64) mk[u][1] |= 1u << (sb - 32); else if (sb < 96) mk[u][2] |= 1u << (sb - 64); else mk[u][3] |= 1u << (sb - 96);
          }
        }
      }
      if (do_imp) {
        for (int rnd = 0; rnd < 13; ++rnd) {
          int mx[2];
#pragma unroll
          for (int u = 0; u < 2; ++u) mx[u] = wave_max_i32(max(v0[u], v1[u]));
#pragma unroll
          for (int u = 0; u < 2; ++u) {
            const unsigned long long b0 = __ballot(v0[u] == mx[u]);
            int sb;
            if (b0) { const int sl = __ffsll((long long)b0) - 1; sb = sl; if (lane == sl) v0[u] = -1; }
            else { const unsigned long long b1 = __ballot(v1[u] == mx[u]); const int sl = __ffsll((long long)b1) - 1; sb = sl + 64; if (lane == sl) v1[u] = -1; }
            if (sb < 32) mk[u][0] |= 1u << sb; else if (sb < 64) mk[u][1] |= 1u << (sb - 32); else if (sb < 96) mk[u][2] |= 1u << (sb - 64); else mk[u][3] |= 1u << (sb - 96);
          }
        }
      }
      if (lane == 0) {
#pragma unroll
        for (int u = 0; u < 2; ++u) {
          const int qq = w * 16 + qi + u;
          sm[qq * 4 + 0] = mk[u][0]; sm[qq * 4 + 1] = mk[u][1]; sm[qq * 4 + 2] = mk[u][2]; sm[qq * 4 + 3] = mk[u][3];
          atomicOr(&un[0], mk[u][0]); atomicOr(&un[1], mk[u][1]); atomicOr(&un[2], mk[u][2]); atomicOr(&un[3], mk[u][3]);
        }
      }
    }
  }
  __syncthreads();
  {
    f32x16 O[2][2]; zero_O(O);
    float m2[2] = {0.f, 0.f}, l2[2] = {0.f, 0.f};
    attn_loop<2, false>(q, O, m2, l2, smem, rowb + C_CKS + g * 64, rowb + C_CVS + g * 64, LDP, 0, cur + 1, q0, lane);
    float sc[2];
#pragma unroll
    for (int nt = 0; nt < 2; ++nt) { const float lt = l2[nt] + __shfl_xor(l2[nt], 32); sc[nt] = gate_of(1, nt) / fmaxf(lt, 1e-30f); }
    y_accum<false>(ybase, O, sc, lane);
  }
  {
    f32x16 O[2][2]; zero_O(O);
    float m2[2] = {0.f, 0.f}, l2[2] = {0.f, 0.f};
    const int t0 = (q0 >= 512) ? (q0 - 512) / 64 : 0;
    attn_loop<1, false>(q, O, m2, l2, smem, rowb + C_CKW + g * 64, rowb + C_CVW + g * 64, LDP, t0, cur + 1, q0, lane);
    float sc[2];
#pragma unroll
    for (int nt = 0; nt < 2; ++nt) { const float lt = l2[nt] + __shfl_xor(l2[nt], 32); sc[nt] = gate_of(2, nt) / fmaxf(lt, 1e-30f); }
    y_accum<false>(ybase, O, sc, lane);
  }
  __syncthreads();
}

__device__ __forceinline__ float ret_log2g(int h) { return log2f(1.f - exp2f(-5.f - (float)h)); }

__device__ __forceinline__ void ret_state_unit(const Params& p, int unit, unsigned char* smem) {
  const int t = TIDX, lane = t & 63, w = WAVE, r = lane & 31, hh = lane >> 5;
  const int n = unit & 63, bh = unit >> 6, b = bh >> 2, h = bh & 3;
  const bf16_t* P = (const bf16_t*)(p.ws + OFF_P);
  const bf16_t* rowb = P + ((size_t)b * T_SEQ + n * 128) * LDP;
  bf16_t* Vt = (bf16_t*)smem;
  bf16_t* Kt = (bf16_t*)(smem + 34816);
  const float l2g = ret_log2g(h);
  __syncthreads();
#pragma unroll
  for (int i = 0; i < 8; ++i) {
    const int idx = t + 256 * i, tok = idx >> 4, c = idx & 15;
    const u32x4 v = *(const u32x4*)(rowb + (size_t)tok * LDP + C_DV + h * 128 + c * 8);
#pragma unroll
    for (int j = 0; j < 4; ++j) {
      Vt[(8 * c + 2 * j) * 136 + tok] = (bf16_t)(v[j] & 0xffffu);
      Vt[(8 * c + 2 * j + 1) * 136 + tok] = (bf16_t)(v[j] >> 16);
    }
  }
#pragma unroll
  for (int i = 0; i < 4; ++i) {
    const int idx = t + 256 * i, tok = idx >> 3, c = idx & 7;
    const u32x4 v = *(const u32x4*)(rowb + (size_t)tok * LDP + C_DK + h * 64 + c * 8);
    const float z = exp2f((float)(127 - tok) * l2g);
#pragma unroll
    for (int j = 0; j < 4; ++j) {
      Kt[(8 * c + 2 * j) * 136 + tok] = f2bf(__uint_as_float(v[j] << 16) * z);
      Kt[(8 * c + 2 * j + 1) * 136 + tok] = f2bf(__uint_as_float(v[j] & 0xffff0000u) * z);
    }
  }
  __syncthreads();
  f32x16 acc[2];
#pragma unroll
  for (int ct = 0; ct < 2; ++ct)
#pragma unroll
    for (int i = 0; i < 16; ++i) acc[ct][i] = 0.f;
#pragma unroll
  for (int ks = 0; ks < 8; ++ks) {
    const bf16x8 a = *(const bf16x8*)(Vt + (32 * w + r) * 136 + 16 * ks + 8 * hh);
#pragma unroll
    for (int ct = 0; ct < 2; ++ct) {
      const bf16x8 bb = *(const bf16x8*)(Kt + (32 * ct + r) * 136 + 16 * ks + 8 * hh);
      acc[ct] = MFMA32(a, bb, acc[ct]);
    }
  }
  bf16_t* RT = (bf16_t*)(p.ws + OFF_RT) + ((size_t)bh * 64 + n) * 8192;
#pragma unroll
  for (int ct = 0; ct < 2; ++ct)
#pragma unroll
    for (int i = 0; i < 16; ++i) {
      const int dv = 32 * w + (i & 3) + 8 * (i >> 2) + 4 * hh;
      RT[dv * 64 + 32 * ct + r] = f2bf(acc[ct][i]);
    }
}

__device__ __forceinline__ void ret_scan(const Params& p) {
  bf16_t* RT = (bf16_t*)(p.ws + OFF_RT);
  for (int i = blockIdx.x * NTHREADS + TIDX; i < 16 * 8192; i += gridDim.x * NTHREADS) {
    const int bh = i >> 13, e = i & 8191, h = bh & 3;
    const float decay = exp2f(128.f * ret_log2g(h));
    bf16_t* ptr = RT + (size_t)bh * 64 * 8192 + e;
    float rr = 0.f;
    for (int n0 = 0; n0 < 64; n0 += 16) {
      float v[16];
#pragma unroll
      for (int j = 0; j < 16; ++j) v[j] = bf2f(ptr[(size_t)(n0 + j) * 8192]);
#pragma unroll
      for (int j = 0; j < 16; ++j) { ptr[(size_t)(n0 + j) * 8192] = f2bf(rr); rr = rr * decay + v[j]; }
    }
  }
}

__device__ __forceinline__ void ret_out_unit(const Params& p, int l, int unit, unsigned char* smem, int ocol = C_DG) {
  const int t = TIDX, lane = t & 63, w = WAVE, r = lane & 31, hh = lane >> 5;
  const int n = unit & 63, bh = unit >> 6, b = bh >> 2, h = bh & 3;
  bf16_t* P = (bf16_t*)(p.ws + OFF_P);
  bf16_t* rowb = P + ((size_t)b * T_SEQ + n * 128) * LDP;
  const bf16_t* RT = (const bf16_t*)(p.ws + OFF_RT) + ((size_t)bh * 64 + n) * 8192;
  unsigned char* Ks = smem;
  bf16_t* Vt = (bf16_t*)(smem + 16384);
  unsigned char* Rs = smem + 50176;
  const float l2g = ret_log2g(h);
  __syncthreads();
#pragma unroll
  for (int i = 0; i < 4; ++i) {
    const int idx = t + 256 * i, row = idx >> 3, c = idx & 7;
    *(u32x4*)(Ks + swz(row, c)) = *(const u32x4*)(rowb + (size_t)row * LDP + C_DK + h * 64 + c * 8);
    *(u32x4*)(Rs + swz(row, c)) = *(const u32x4*)(RT + row * 64 + c * 8);
  }
#pragma unroll
  for (int i = 0; i < 8; ++i) {
    const int idx = t + 256 * i, tok = idx >> 4, c = idx & 15;
    const u32x4 v = *(const u32x4*)(rowb + (size_t)tok * LDP + C_DV + h * 128 + c * 8);
#pragma unroll
    for (int j = 0; j < 4; ++j) {
      Vt[(8 * c + 2 * j) * 132 + tok] = (bf16_t)(v[j] & 0xffffu);
      Vt[(8 * c + 2 * j + 1) * 132 + tok] = (bf16_t)(v[j] >> 16);
    }
  }
  const int cq = 32 * w + r;
  bf16x8 qf[4];
#pragma unroll
  for (int ks = 0; ks < 4; ++ks) qf[ks] = *(const bf16x8*)(rowb + (size_t)cq * LDP + C_DQ + h * 64 + 16 * ks + 8 * hh);
  __syncthreads();
  f32x16 O[4];
#pragma unroll
  for (int dt = 0; dt < 4; ++dt) {
#pragma unroll
    for (int i = 0; i < 16; ++i) O[dt][i] = 0.f;
#pragma unroll
    for (int ks = 0; ks < 4; ++ks) {
      const bf16x8 a = *(const bf16x8*)(Rs + swz(32 * dt + r, 2 * ks + hh));
      O[dt] = MFMA32(a, qf[ks], O[dt]);
    }
  }
  const float xi = exp2f((float)(cq + 1) * l2g);
#pragma unroll
  for (int dt = 0; dt < 4; ++dt) O[dt] = O[dt] * xi;
  for (int mt = 0; mt <= w; ++mt) {
    f32x16 S;
#pragma unroll
    for (int i = 0; i < 16; ++i) S[i] = 0.f;
#pragma unroll
    for (int ks = 0; ks < 4; ++ks) {
      const bf16x8 a = *(const bf16x8*)(Ks + swz(32 * mt + r, 2 * ks + hh));
      S = MFMA32(a, qf[ks], S);
    }
    const int dbase = cq - 32 * mt - 4 * hh;
#pragma unroll
    for (int i = 0; i < 16; ++i) {
      const int d = dbase - ((i & 3) + 8 * (i >> 2));
      S[i] = (d >= 0) ? S[i] * exp2f((float)d * l2g) : 0.f;
    }
#pragma unroll
    for (int s = 0; s < 2; ++s) {
      FragU pf;
      pf.u.x = pack2(S[8 * s + 0], S[8 * s + 1]); pf.u.y = pack2(S[8 * s + 2], S[8 * s + 3]);
      pf.u.z = pack2(S[8 * s + 4], S[8 * s + 5]); pf.u.w = pack2(S[8 * s + 6], S[8 * s + 7]);
#pragma unroll
      for (int dt = 0; dt < 4; ++dt) {
        const bf16_t* a = Vt + (32 * dt + r) * 132 + 32 * mt + 16 * s + 4 * hh;
        const u32x2 lo = *(const u32x2*)a, hi = *(const u32x2*)(a + 8);
        FragU vf; vf.u.x = lo.x; vf.u.y = lo.y; vf.u.z = hi.x; vf.u.w = hi.y;
        O[dt] = MFMA32(vf.b, pf.b, O[dt]);
      }
    }
  }
  float s1 = 0.f;
#pragma unroll
  for (int dt = 0; dt < 4; ++dt)
#pragma unroll
    for (int i = 0; i < 16; ++i) s1 += O[dt][i];
  s1 += __shfl_xor(s1, 32);
  const float mu = s1 * (1.f / 128.f);
  float s2 = 0.f;
#pragma unroll
  for (int dt = 0; dt < 4; ++dt)
#pragma unroll
    for (int i = 0; i < 16; ++i) { const float d = O[dt][i] - mu; s2 += d * d; }
  s2 += __shfl_xor(s2, 32);
  const float rstd = rsqrtf(s2 * (1.f / 128.f) + 1e-6f);
  const float* gn = p.in[I_RETG] + (size_t)l * 512 + h * 128;
  bf16_t* yrow = rowb + (size_t)cq * LDP + C_DG + h * 128;
#pragma unroll
  for (int dt = 0; dt < 4; ++dt)
#pragma unroll
    for (int g4 = 0; g4 < 4; ++g4) {
      const int dv = 32 * dt + 8 * g4 + 4 * hh;
      const u32x2 gt = *(const u32x2*)(yrow + dv);
      const f32x4 gv = *(const f32x4*)(gn + dv);
      const float g0 = __uint_as_float(gt.x << 16), g1 = __uint_as_float(gt.x & 0xffff0000u);
      const float g2 = __uint_as_float(gt.y << 16), g3 = __uint_as_float(gt.y & 0xffff0000u);
      u32x2 o;
      o.x = pack2((O[dt][4 * g4 + 0] - mu) * rstd * gv[0] * siluf_(g0), (O[dt][4 * g4 + 1] - mu) * rstd * gv[1] * siluf_(g1));
      o.y = pack2((O[dt][4 * g4 + 2] - mu) * rstd * gv[2] * siluf_(g2), (O[dt][4 * g4 + 3] - mu) * rstd * gv[3] * siluf_(g3));
      *(u32x2*)(yrow + dv + (ocol - C_DG)) = o;
    }
}

__device__ __forceinline__ void conv_item(const Params& p, int l, int item) {
  bf16_t* P = (bf16_t*)(p.ws + OFF_P);
  const float* cw = p.in[I_CONVW] + (size_t)l * 1536;
  for (int k = TIDX; k < 32 * 64; k += NTHREADS) {
    const int tok = item * 32 + (k >> 6), c = k & 63, pos = tok & (T_SEQ - 1);
    const bf16_t* row = P + (size_t)tok * LDP;
    float z[3][8];
#pragma unroll
    for (int d = 0; d < 3; ++d) {
      if (pos >= d) {
        const u32x4 xv = *(const u32x4*)(row - (size_t)d * LDP + C_BX + c * 8);
        const u32x4 cv = *(const u32x4*)(row - (size_t)d * LDP + C_BC + c * 8);
#pragma unroll
        for (int j = 0; j < 4; ++j) {
          z[d][2 * j] = __uint_as_float(xv[j] << 16) * __uint_as_float(cv[j] << 16);
          z[d][2 * j + 1] = __uint_as_float(xv[j] & 0xffff0000u) * __uint_as_float(cv[j] & 0xffff0000u);
        }
      } else {
#pragma unroll
        for (int j = 0; j < 8; ++j) z[d][j] = 0.f;
      }
    }
    const u32x4 bv = *(const u32x4*)(row + C_BB + c * 8);
    float y[8];
#pragma unroll
    for (int j = 0; j < 8; ++j) {
      const int ch = c * 8 + j;
      const float bj = (j & 1) ? __uint_as_float(bv[j >> 1] & 0xffff0000u) : __uint_as_float(bv[j >> 1] << 16);
      y[j] = bj * (cw[ch] * z[2][j] + cw[512 + ch] * z[1][j] + cw[1024 + ch] * z[0][j]);
    }
    u32x4 o; o.x = pack2(y[0], y[1]); o.y = pack2(y[2], y[3]); o.z = pack2(y[4], y[5]); o.w = pack2(y[6], y[7]);
    *(u32x4*)(P + (size_t)tok * LDP + C_BB + c * 8) = o;
  }
}

__device__ __forceinline__ void compress2(const Params& p, int l) {
  const int lane = TIDX & 63;
  const int gw = blockIdx.x * 4 + WAVE, nw = gridDim.x * 4;
  for (int task = gw; task < 2048; task += nw) {
    const int kv = task >> 10, row0 = (task & 1023) * 4;
    const bf16_t* hid = (const bf16_t*)(p.ws + OFF_CMPH) + ((size_t)kv * 4096 + row0) * 256;
    const float* w2 = p.in[kv ? I_WV2 : I_WK2] + (size_t)l * 256 * 64;
    float acc[4] = {0.f, 0.f, 0.f, 0.f};
    for (int k8 = 0; k8 < 32; k8 += 2) {
      u32x4 hv[4][2]; float wv[16];
#pragma unroll
      for (int rr = 0; rr < 4; ++rr)
#pragma unroll
        for (int u = 0; u < 2; ++u) hv[rr][u] = *(const u32x4*)(hid + rr * 256 + (k8 + u) * 8);
#pragma unroll
      for (int u = 0; u < 16; ++u) wv[u] = w2[(k8 * 8 + u) * 64 + lane];
#pragma unroll
      for (int rr = 0; rr < 4; ++rr)
#pragma unroll
        for (int u = 0; u < 2; ++u)
#pragma unroll
          for (int j = 0; j < 4; ++j) {
            acc[rr] += __uint_as_float(hv[rr][u][j] << 16) * wv[u * 8 + 2 * j];
            acc[rr] += __uint_as_float(hv[rr][u][j] & 0xffff0000u) * wv[u * 8 + 2 * j + 1];
          }
    }
#pragma unroll
    for (int rr = 0; rr < 4; ++rr) {
      float a = acc[rr];
      if (kv == 0) {
        float ss = a * a;
#pragma unroll
        for (int o = 32; o >= 1; o >>= 1) ss += __shfl_xor(ss, o);
        a = a * rsqrtf(ss * (1.f / 64.f) + 1e-6f) * p.in[I_NSAKG][l * 192 + lane];
      }
      bf16_t* dst = (bf16_t*)(p.ws + (kv ? OFF_VCMP : OFF_KCMP)) + (size_t)(row0 + rr) * 64 + lane;
      *dst = f2bf(a);
    }
  }
}

#define XB_TMO      128
#define XB_XCNT(j)  (256  + 64 * (j))
#define XB_XSUB(j)  (1280 + 64 * (j))
#define XB_XGEN(j)  (2304 + 64 * (j))
#define XB_TOP      3328
#define XB_TOPGEN   3392
#define XCD_BAR_WORDS 3456
#define XB_SPIN_CAP (1u << 20)
__device__ __forceinline__ unsigned xb_ld(unsigned* p)              { return __hip_atomic_load(p, __ATOMIC_RELAXED, __HIP_MEMORY_SCOPE_AGENT); }
__device__ __forceinline__ unsigned xb_add(unsigned* p, unsigned v) { return __hip_atomic_fetch_add(p, v, __ATOMIC_RELAXED, __HIP_MEMORY_SCOPE_AGENT); }
__device__ __forceinline__ unsigned xb_xcc_id() { return (unsigned)__builtin_amdgcn_s_getreg((3 << 11) | 20) & 0xFu; }
#define XB_SPIN(cond, bar) do { unsigned _sp = 0; while (cond) { __builtin_amdgcn_s_sleep(1); \
    if ((++_sp & 255u) == 0u) { if (xb_ld(&(bar)[XB_TMO])) break; if (_sp > XB_SPIN_CAP) { atomicAdd(&(bar)[XB_TMO], 1u); break; } } } } while (0)
struct XcdBarrier { unsigned* bar; unsigned x; volatile LDS_AS unsigned* st; };
__device__ __forceinline__ XcdBarrier xcd_barrier_post(unsigned* bar, volatile LDS_AS unsigned* st) {
  XcdBarrier b; b.bar = bar; b.x = xb_xcc_id(); b.st = st;
  if (TIDX == 0) (void)xb_add(&bar[XB_XCNT(b.x)], 1u);
  return b;
}
__device__ __forceinline__ void xcd_barrier_complete(unsigned* bar, unsigned x, unsigned& nloc, unsigned& nx) {
  const unsigned G = gridDim.x * gridDim.y * gridDim.z;
  unsigned sum, cnt, mine, sp = 0u;
  for (;;) {
    sum = 0u; cnt = 0u; mine = 0u;
#pragma unroll
    for (unsigned j = 0; j < 16; ++j) { const unsigned c = xb_ld(&bar[XB_XCNT(j)]); sum += c; cnt += (c > 0u) ? 1u : 0u; mine = (j == x) ? c : mine; }
    if (sum == G) break;
    __builtin_amdgcn_s_sleep(1);
    if ((++sp & 255u) == 0u) { if (xb_ld(&bar[XB_TMO])) break; if (sp > XB_SPIN_CAP) { atomicAdd(&bar[XB_TMO], 1u); break; } }
  }
  nloc = mine > 0u ? mine : 1u; nx = cnt > 0u ? cnt : 1u;
}
__device__ __forceinline__ void xcd_barrier(const XcdBarrier& b) {
  asm volatile("s_waitcnt vmcnt(0)" ::: "memory");
  __syncthreads();
  if (TIDX == 0) {
    unsigned* bar = b.bar;
    __builtin_amdgcn_s_waitcnt(0);
    unsigned nloc = b.st[0], nx = b.st[1];
    if (nloc == 0u) { xcd_barrier_complete(bar, b.x, nloc, nx); b.st[0] = nloc; b.st[1] = nx; }
    const unsigned old = xb_add(&bar[XB_XSUB(b.x)], 1u);
    const unsigned gen = old / nloc;
    if (old + 1u == (gen + 1u) * nloc) {
      __builtin_amdgcn_fence(__ATOMIC_RELEASE, "agent");
      asm volatile("s_waitcnt vmcnt(0)" ::: "memory");
      const unsigned og = xb_add(&bar[XB_TOP], 1u);
      const unsigned tg = og / nx;
      if (og + 1u == (tg + 1u) * nx) xb_add(&bar[XB_TOPGEN], 1u);
      else XB_SPIN(xb_ld(&bar[XB_TOPGEN]) == tg, bar);
      __builtin_amdgcn_fence(__ATOMIC_ACQUIRE, "agent");
      xb_add(&bar[XB_XGEN(b.x)], 1u);
      asm volatile("s_waitcnt vmcnt(0)" ::: "memory");
    } else {
      XB_SPIN(xb_ld(&bar[XB_XGEN(b.x)]) == gen, bar);
      __builtin_amdgcn_fence(__ATOMIC_ACQUIRE, "agent");
      asm volatile("s_waitcnt vmcnt(0)" ::: "memory");
    }
  }
  __syncthreads();
}

constexpr int PH_PER_LAYER = 14;
__device__ __forceinline__ void run_phase(const Params& p, int ph, unsigned char* smem) {
  const int l = ph / PH_PER_LAYER, k = ph % PH_PER_LAYER;
  unsigned char* ws = p.ws;
  bf16_t* U = (bf16_t*)(ws + OFF_U);
  bf16_t* P = (bf16_t*)(ws + OFF_P);
  const float* xcur = (l == 0) ? p.in[I_X] : p.out;
  switch (k) {
    case 0: phase_convert(p, l, smem); break;
    case 1: phase_norm(xcur, p.in[I_F1N] + l * DM, U); break;
    case 2: phase_ffn_up_wide(U, (const bf16_t*)(ws + OFF_WGU1), P, smem); break;
    case 3: phase_gemm_resid_wide(P, DFF, (const bf16_t*)(ws + OFF_WD1), DFF, xcur, p.out, 0.5f, smem); break;
    case 4: phase_norm(p.out, p.in[I_MIXN] + l * DM, U); break;
    case 5: phase_proj(p, l, smem); break;
    case 6: {
      const int nitems = 128 + 1024 + 1024 + 1024;
      for (int it = blockIdx.x; it < nitems; it += gridDim.x) {
        if (it < 128) compress_gemm1_tile(p, it, smem);
        else if (it < 128 + 1024) swa_unit(p, l, it - 128, smem);
        else if (it < 128 + 1024 + 1024) ret_state_unit(p, it - 1152, smem);
        else conv_item(p, l, it - 2176);
        __syncthreads();
      }
    } break;
    case 7: compress2(p, l); ret_scan(p); break;
    case 8: {
      const int G = gridDim.x;
#ifdef DRY_M3
      { int rnd2 = 0;
        for (int base = 0; base < 1024; base += G, ++rnd2) {
          const int it = base + ((rnd2 & 1) ? (G - 1 - (int)blockIdx.x) : (int)blockIdx.x);
          if (it < 1024) nsa_unit(p, l, it, smem, C_BX);
          __syncthreads();
        }
        for (int it = blockIdx.x; it < 1024; it += gridDim.x) { ret_out_unit(p, l, it, smem, C_BC); __syncthreads(); }
      }
#endif
      int rnd = 0;
      for (int base = 0; base < 1024; base += G, ++rnd) {
        const int it = base + ((rnd & 1) ? (G - 1 - (int)blockIdx.x) : (int)blockIdx.x);
        if (it < 1024) nsa_unit(p, l, it, smem);
        __syncthreads();
      }
      for (int it = blockIdx.x; it < 1024; it += gridDim.x) {
        ret_out_unit(p, l, it, smem);
        __syncthreads();
      }
    } break;
    case 9: phase_merge(p, l, smem); break;
    case 10: phase_gemm_resid_wide(P + C_MERGED, LDP, (const bf16_t*)(ws + OFF_WOUT), DM, p.out, p.out, 1.0f, smem); break;
    case 11: phase_norm(p.out, p.in[I_F2N] + l * DM, U); break;
    case 12: phase_ffn_up_wide(U, (const bf16_t*)(ws + OFF_WGU2), P, smem); break;
    case 13: phase_gemm_resid_wide(P, DFF, (const bf16_t*)(ws + OFF_WD2), DFF, p.out, p.out, 0.5f, smem); break;
  }
}

__global__ void __launch_bounds__(NTHREADS, 2) fwd_megakernel(Params p, int ph0, int ph1) {
  __shared__ __attribute__((aligned(16))) unsigned char smem[SMEM_BYTES];
  __shared__ uint4 xb_words;
  cg::grid_group grid = cg::this_grid();
  if (TIDX == 0) xb_words = make_uint4(0u, 0u, 0u, 0u);
  __syncthreads();
  XcdBarrier xb = xcd_barrier_post((unsigned*)(p.ws + OFF_BAR), (volatile LDS_AS unsigned*)&xb_words);
  for (int ph = ph0; ph <= ph1; ++ph) {
    run_phase(p, ph, smem);
#ifdef DBL_PHASE
    if (ph == DBL_PHASE) { xcd_barrier(xb); run_phase(p, ph, smem); }
#endif
#ifdef XSYNC
    xcd_barrier(xb);
#endif
    if (ph < ph1) {
      if (ph == ph0) grid.sync();
      else xcd_barrier(xb);
    }
  }
}

extern "C" void kernel_launch(void* const* d_in, const int* in_sizes, int n_in, void* d_out, int out_size, void* d_ws, size_t ws_size,
                              hipStream_t stream) {
  static int grid_blocks = 0;
  if (!grid_blocks) {
    int dev = 0, cus = 0, per_cu = 0;
    hipGetDevice(&dev);
    hipDeviceGetAttribute(&cus, hipDeviceAttributeMultiprocessorCount, dev);
    hipOccupancyMaxActiveBlocksPerMultiprocessor(&per_cu, fwd_megakernel, NTHREADS, 0);
    if (per_cu > 2) per_cu = 2;
    grid_blocks = cus * per_cu;
  }
  if (ws_size < WS_NEED || n_in < 27 || grid_blocks <= 0) { fprintf(stderr, "bad setup ws=%zu need=%zu grid=%d\n", ws_size, (size_t)WS_NEED, grid_blocks); return; }
  Params p{};
  for (int i = 0; i < 27; ++i) p.in[i] = (const float*)d_in[i];
  p.out = (float*)d_out;
  p.ws = (unsigned char*)d_ws;
  for (int i = 0; i < 32; ++i) p.inv_freq[i] = pow(10000.0, -(double)i / 32.0);
  int ph0 = 0, ph1 = 2 * PH_PER_LAYER - 1;
  void* args[] = {&p, &ph0, &ph1};
  hipMemsetAsync((unsigned char*)d_ws + OFF_BAR, 0, 16384, stream);
  hipError_t e = hipLaunchCooperativeKernel((void*)fwd_megakernel, dim3(grid_blocks), dim3(NTHREADS), args, 0, stream);
  if (e != hipSuccess) fprintf(stderr, "cooperative launch failed: %s (grid %d)\n", hipGetErrorString(e), grid_blocks);
}
```

```cpp
#include <hip/hip_runtime.h>
#include <hip/hip_cooperative_groups.h>
#include <stdint.h>
#include <math.h>
#include <cstdio>
namespace cg = cooperative_groups;

typedef unsigned short bf16_t;
typedef short bf16x8 __attribute__((ext_vector_type(8)));
typedef short bf16x4 __attribute__((ext_vector_type(4)));
typedef float f32x4 __attribute__((ext_vector_type(4)));
typedef float f32x16 __attribute__((ext_vector_type(16)));
typedef unsigned u32x4 __attribute__((ext_vector_type(4)));
typedef unsigned u32x2 __attribute__((ext_vector_type(2)));

#define NTHREADS 256
#ifndef LEANV
#define LEANV 0
#endif
#ifndef DBG_MASK
#define DBG_MASK 0
#endif
__device__ __forceinline__ int launder_tid() { int t = threadIdx.x; asm volatile("" : "+v"(t)); return t; }
#define TIDX launder_tid()
__device__ __forceinline__ int wave_id() { return __builtin_amdgcn_readfirstlane(launder_tid() >> 6); }
#define WAVE wave_id()
#define SMEM_BYTES 69632

constexpr int T_SEQ = 8192;
constexpr int MTOK = 32768;
constexpr int DM = 1024;
constexpr int DFF = 2816;
constexpr int LDP = 5248;
constexpr int INTOT = 9240;
constexpr int C_AQ = 0, C_AK = 512, C_AV = 640, C_BX = 768, C_BB = 1280, C_BC = 1792, C_CQ = 2304, C_CKC = 2816,
              C_CVC = 2944, C_CKS = 3072, C_CVS = 3200, C_CKW = 3328, C_CVW = 3456, C_CG = 3584, C_DQ = 3712,
              C_DK = 3968, C_DV = 4224, C_DG = 4736, C_MERGED = 2816;

constexpr size_t OFF_WGU1 = 0;
constexpr size_t OFF_WD1 = OFF_WGU1 + (size_t)5632 * 1024 * 2;
constexpr size_t OFF_WIN = OFF_WD1 + (size_t)1024 * 2816 * 2;
constexpr size_t OFF_WGATE = OFF_WIN + (size_t)LDP * 1024 * 2;
constexpr size_t OFF_WBR = OFF_WGATE + (size_t)4096 * 1024 * 2;
constexpr size_t OFF_WOUT = OFF_WBR + (size_t)4 * 1024 * 512 * 2;
constexpr size_t OFF_WGU2 = OFF_WOUT + (size_t)1024 * 1024 * 2;
constexpr size_t OFF_WD2 = OFF_WGU2 + (size_t)5632 * 1024 * 2;
constexpr size_t OFF_WCK1 = OFF_WD2 + (size_t)1024 * 2816 * 2;
constexpr size_t OFF_WCV1 = OFF_WCK1 + (size_t)256 * 2048 * 2;
constexpr size_t OFF_U = OFF_WCV1 + (size_t)256 * 2048 * 2;
constexpr size_t OFF_P = OFF_U + (size_t)MTOK * 1024 * 2;
constexpr size_t OFF_RT = OFF_P + (size_t)(MTOK + 64) * LDP * 2;
constexpr size_t OFF_CMPH = OFF_RT + (size_t)16 * 64 * 8192 * 2;
constexpr size_t OFF_KCMP = OFF_CMPH + (size_t)2 * 4096 * 256 * 2;
constexpr size_t OFF_VCMP = OFF_KCMP + (size_t)8 * 512 * 64 * 2;
constexpr size_t OFF_ROPE = OFF_VCMP + (size_t)8 * 512 * 64 * 2;
constexpr size_t OFF_CB1 = OFF_ROPE + (size_t)8192 * 32 * 8;
constexpr size_t OFF_BAR = OFF_CB1 + 4096;
constexpr size_t WS_NEED = OFF_BAR + 16384;

struct Params {
  const float* in[27];
  float* out;
  unsigned char* ws;
  double inv_freq[32];
};

enum { I_X = 0, I_F1N, I_F1G, I_F1U, I_F1D, I_MIXN, I_WIN, I_MGB, I_SWAQG, I_SWAKG, I_SINK, I_CONVW, I_NSAQG, I_NSAKG,
       I_POSK, I_POSV, I_WK1, I_WK2, I_WV1, I_WV2, I_RETG, I_WBR, I_WOUT, I_F2N, I_F2G, I_F2U, I_F2D };

__device__ __forceinline__ unsigned short f2bf(float f) {
  unsigned u = __float_as_uint(f);
  u += 0x7fffu + ((u >> 16) & 1u);
  return (unsigned short)(u >> 16);
}
__device__ __forceinline__ float bf2f(unsigned short h) { return __uint_as_float(((unsigned)h) << 16); }
__device__ __forceinline__ unsigned pack2(float lo, float hi) { return (unsigned)f2bf(lo) | ((unsigned)f2bf(hi) << 16); }
__device__ __forceinline__ float sigmoidf_(float x) { return 1.f / (1.f + __expf(-x)); }
__device__ __forceinline__ float siluf_(float x) { return x / (1.f + __expf(-x)); }
__device__ __forceinline__ float gelu_tanh(float x) {
  float u = 0.7978845608028654f * (x + 0.044715f * x * x * x);
  float t = 1.f - 2.f / (1.f + __expf(2.f * u));
  return 0.5f * x * (1.f + t);
}
__device__ __forceinline__ int swz(int row, int chunk) { return row * 128 + (((chunk) ^ ((row >> 1) & 7)) << 4); }

__device__ __forceinline__ void convert_job(const float* src0, const float* src1, int Nsrc, int K, bf16_t* dst, int Ndst, int kind, int coloff, unsigned char* smem, bool pack32 = false, int pack_rows = 1 << 30) {
  const int t = TIDX;
  const int nkb = K >> 6, nrb = Ndst >> 6;
  const int nunits = nkb * nrb;
  bf16_t* tl = (bf16_t*)smem;
  const int n4 = (t & 15) * 4, kr = t >> 4;
  for (int u = blockIdx.x; u < nunits; u += gridDim.x) {
    const int rb = u / nkb, kb = u % nkb;
    __syncthreads();
    const int r = rb * 64 + n4;
    const float* sp = src0; int col;
    if (kind == 0) col = r + coloff;
    else if (kind == 1) { const int sel = (r >> 4) & 1; col = 16 * (r >> 5) + (r & 15); sp = sel ? src1 : src0; }
    else { col = (r < 3608) ? r : ((r < 3712) ? -1 : r - 104); }
    f32x4 v[4];
#pragma unroll
    for (int ps = 0; ps < 4; ++ps) {
      v[ps] = (f32x4){0.f, 0.f, 0.f, 0.f};
      if (col >= 0) v[ps] = *(const f32x4*)(sp + (size_t)(kb * 64 + ps * 16 + kr) * Nsrc + col);
    }
#pragma unroll
    for (int ps = 0; ps < 4; ++ps)
#pragma unroll
      for (int e = 0; e < 4; ++e) tl[(n4 + e) * 66 + ps * 16 + kr] = f2bf(v[ps][e]);
    __syncthreads();
#pragma unroll
    for (int i = 0; i < 2; ++i) {
      const int n = (t >> 3) + 32 * i, c = t & 7;
      const unsigned* lp = (const unsigned*)(tl + n * 66 + c * 8);
      u32x4 o; o.x = lp[0]; o.y = lp[1]; o.z = lp[2]; o.w = lp[3];
      if (!pack32 || rb * 64 + n >= pack_rows) *(u32x4*)(dst + (size_t)(rb * 64 + n) * K + kb * 64 + c * 8) = o;
      else {
        const int nn = rb * 64 + n, rowi = nn & 15, ch = c & 3, phys = ch ^ ((0x1320 >> (((rowi >> 2) & 3) * 4)) & 3);
        *(u32x4*)(dst + ((size_t)(nn >> 4) * (K >> 5) + kb * 2 + (c >> 2)) * 512 + rowi * 32 + phys * 8) = o;
      }
    }
  }
}

__device__ __forceinline__ void phase_convert(const Params& p, int l, unsigned char* smem) {
  unsigned char* ws = p.ws;
  convert_job(p.in[I_F1G] + (size_t)l * DM * DFF, p.in[I_F1U] + (size_t)l * DM * DFF, DFF, DM, (bf16_t*)(ws + OFF_WGU1), 5632, 1, 0, smem, true);
  convert_job(p.in[I_F1D] + (size_t)l * DFF * DM, nullptr, DM, DFF, (bf16_t*)(ws + OFF_WD1), 1024, 0, 0, smem, true);
  convert_job(p.in[I_WIN] + (size_t)l * DM * INTOT, nullptr, INTOT, DM, (bf16_t*)(ws + OFF_WIN), LDP, 2, 0, smem, true, 5120);
  convert_job(p.in[I_WIN] + (size_t)l * DM * INTOT, nullptr, INTOT, DM, (bf16_t*)(ws + OFF_WGATE), 4096, 0, 5144, smem);
  for (int i = 0; i < 4; ++i)
    convert_job(p.in[I_WBR] + ((size_t)l * 4 + i) * 512 * DM, nullptr, DM, 512, (bf16_t*)(ws + OFF_WBR) + (size_t)i * 1024 * 512, 1024, 0, 0, smem);
  convert_job(p.in[I_WOUT] + (size_t)l * DM * DM, nullptr, DM, DM, (bf16_t*)(ws + OFF_WOUT), 1024, 0, 0, smem, true);
  convert_job(p.in[I_F2G] + (size_t)l * DM * DFF, p.in[I_F2U] + (size_t)l * DM * DFF, DFF, DM, (bf16_t*)(ws + OFF_WGU2), 5632, 1, 0, smem, true);
  convert_job(p.in[I_F2D] + (size_t)l * DFF * DM, nullptr, DM, DFF, (bf16_t*)(ws + OFF_WD2), 1024, 0, 0, smem, true);
  convert_job(p.in[I_WK1] + (size_t)l * 2048 * 256, nullptr, 256, 2048, (bf16_t*)(ws + OFF_WCK1), 256, 0, 0, smem);
  convert_job(p.in[I_WV1] + (size_t)l * 2048 * 256, nullptr, 256, 2048, (bf16_t*)(ws + OFF_WCV1), 256, 0, 0, smem);
  if (blockIdx.x < 8) {
    __syncthreads();
    const int kv = blockIdx.x >> 2, jc = blockIdx.x & 3, t = TIDX, j = jc * 64 + (t & 63), kq = t >> 6;
    const float* pe = p.in[kv ? I_POSV : I_POSK] + (size_t)l * 2048 + kq * 512;
    const float* w1 = p.in[kv ? I_WV1 : I_WK1] + (size_t)l * 2048 * 256 + (size_t)kq * 512 * 256 + j;
    float sacc = 0.f;
    for (int k0 = 0; k0 < 512; k0 += 16) {
      float wv[16], pv[16];
#pragma unroll
      for (int u = 0; u < 16; ++u) { wv[u] = w1[(size_t)(k0 + u) * 256]; pv[u] = pe[k0 + u]; }
#pragma unroll
      for (int u = 0; u < 16; ++u) sacc += pv[u] * wv[u];
    }
    float* red = (float*)smem;
    red[kq * 64 + (t & 63)] = sacc;
    __syncthreads();
    if (t < 64) ((float*)(ws + OFF_CB1))[kv * 256 + jc * 64 + t] = ((red[t] + red[64 + t]) + red[128 + t]) + red[192 + t];
  }
  if (l == 0) {
    float2* tab = (float2*)(ws + OFF_ROPE);
    for (int i = blockIdx.x * NTHREADS + TIDX; i < 8192 * 32; i += gridDim.x * NTHREADS) {
      const int pos = i >> 5, f = i & 31;
      double rev = (double)pos * p.inv_freq[f] * 0.15915494309189535;
      rev = rev - floor(rev);
      float fr = (float)rev;
      tab[i] = make_float2(__builtin_amdgcn_cosf(fr), __builtin_amdgcn_sinf(fr));
    }
  }
}

__device__ __forceinline__ void phase_norm(const float* x, const float* gain, bf16_t* dst) {
  const int lane = TIDX & 63;
  const int gw = blockIdx.x * 4 + WAVE, nw = gridDim.x * 4;
  f32x4 g[4];
#pragma unroll
  for (int i = 0; i < 4; ++i) g[i] = *(const f32x4*)(gain + i * 256 + lane * 4);
  for (int row = gw; row < MTOK; row += 2 * nw) {
    const int row2 = row + nw;
    const bool has2 = row2 < MTOK;
    const float* xr = x + (size_t)row * DM; const float* xr2 = x + (size_t)(has2 ? row2 : row) * DM;
    f32x4 v[4], v2[4]; float ss = 0.f, ss2 = 0.f;
#pragma unroll
    for (int i = 0; i < 4; ++i) { v[i] = *(const f32x4*)(xr + i * 256 + lane * 4); v2[i] = *(const f32x4*)(xr2 + i * 256 + lane * 4); }
#pragma unroll
    for (int i = 0; i < 4; ++i) {
      ss += v[i][0] * v[i][0] + v[i][1] * v[i][1] + v[i][2] * v[i][2] + v[i][3] * v[i][3];
      ss2 += v2[i][0] * v2[i][0] + v2[i][1] * v2[i][1] + v2[i][2] * v2[i][2] + v2[i][3] * v2[i][3];
    }
#pragma unroll
    for (int o = 32; o >= 1; o >>= 1) { ss += __shfl_xor(ss, o); ss2 += __shfl_xor(ss2, o); }
    const float rs = rsqrtf(ss * (1.f / 1024.f) + 1e-6f), rs2 = rsqrtf(ss2 * (1.f / 1024.f) + 1e-6f);
#pragma unroll
    for (int i = 0; i < 4; ++i) {
      u32x2 o; o.x = pack2(v[i][0] * rs * g[i][0], v[i][1] * rs * g[i][1]); o.y = pack2(v[i][2] * rs * g[i][2], v[i][3] * rs * g[i][3]);
      *(u32x2*)(dst + (size_t)row * DM + i * 256 + lane * 4) = o;
      if (has2) {
        u32x2 o2; o2.x = pack2(v2[i][0] * rs2 * g[i][0], v2[i][1] * rs2 * g[i][1]); o2.y = pack2(v2[i][2] * rs2 * g[i][2], v2[i][3] * rs2 * g[i][3]);
        *(u32x2*)(dst + (size_t)row2 * DM + i * 256 + lane * 4) = o2;
      }
    }
  }
}

#define LDS_AS __attribute__((address_space(3)))
template <int AMODE, int NI>
__device__ __forceinline__ void gemm_mainloop(f32x4 (&acc)[4][NI], const bf16_t* __restrict__ A, long lda, long lda2,
                                              const bf16_t* __restrict__ B, long ldb, int K, int m0, int n0, unsigned char* smem,
                                              bool pre = false, int nm0 = -1, int nn0 = 0) {
  const int lane = TIDX & 63, w = WAVE, wr = w >> 1, wc = w & 1, fr = lane & 15, fq = lane >> 4;
  const int lr = lane >> 3, ph = lane & 7;
  const bf16_t* ap[4]; const bf16_t* bp[NI];
#pragma unroll
  for (int j = 0; j < 4; ++j) {
    const int row = w * 32 + j * 8 + lr, R = m0 + row, c = ph ^ ((row >> 1) & 7);
    if (AMODE == 0) ap[j] = A + (size_t)R * lda + c * 8;
    else { const int bg = R >> 9, n = R & 511; ap[j] = A + ((size_t)(bg >> 1) * T_SEQ + n * 16) * lda + (bg & 1) * 64 + c * 8; }
  }
#pragma unroll
  for (int j = 0; j < NI; ++j) {
    const int row = w * 8 * NI + j * 8 + lr, c = ph ^ ((row >> 1) & 7);
    bp[j] = B + (size_t)(n0 + row) * ldb + c * 8;
  }
  unsigned char* As = smem; unsigned char* Bs = smem + 32768;
  const int a_l = (w * 32) * 128 + lane * 16, b_l = (w * 8 * NI) * 128 + lane * 16;
  const int nk = K >> 6;
  auto issue = [&](int kt, int buf) {
#pragma unroll
    for (int j = 0; j < 4; ++j)
      __builtin_amdgcn_global_load_lds((const unsigned*)(ap[j] + (size_t)kt * lda2), (LDS_AS unsigned*)(As + buf * 16384 + a_l + j * 1024), 16, 0, 0);
#pragma unroll
    for (int j = 0; j < NI; ++j)
      __builtin_amdgcn_global_load_lds((const unsigned*)(bp[j] + (size_t)kt * 64), (LDS_AS unsigned*)(Bs + buf * 16384 + b_l + j * 1024), 16, 0, 0);
  };
  if (!pre) {
    __syncthreads();
    issue(0, 0);
  }
  for (int kt = 0; kt < nk; ++kt) {
    const int cur = kt & 1;
    __syncthreads();
    const unsigned char* a_s = As + cur * 16384; const unsigned char* b_s = Bs + cur * 16384;
    bf16x8 xf[2][4], wf[2][NI];
#pragma unroll
    for (int ks = 0; ks < 2; ++ks) {
#pragma unroll
      for (int i = 0; i < 4; ++i) xf[ks][i] = *(const bf16x8*)(a_s + swz(wr * 64 + 16 * i + fr, ks * 4 + fq));
#pragma unroll
      for (int i = 0; i < NI; ++i) wf[ks][i] = *(const bf16x8*)(b_s + swz(wc * 16 * NI + 16 * i + fr, ks * 4 + fq));
    }
    if (kt + 1 < nk) issue(kt + 1, cur ^ 1);
    else if (nm0 >= 0) {
      const long da = (long)(nm0 - m0) * lda, db = (long)(nn0 - n0) * ldb;
#pragma unroll
      for (int j = 0; j < 4; ++j)
        __builtin_amdgcn_global_load_lds((const unsigned*)(ap[j] + da), (LDS_AS unsigned*)(As + a_l + j * 1024), 16, 0, 0);
#pragma unroll
      for (int j = 0; j < NI; ++j)
        __builtin_amdgcn_global_load_lds((const unsigned*)(bp[j] + db), (LDS_AS unsigned*)(Bs + b_l + j * 1024), 16, 0, 0);
    }
#pragma unroll
    for (int ks = 0; ks < 2; ++ks)
#pragma unroll
      for (int mi = 0; mi < 4; ++mi)
#pragma unroll
        for (int ni = 0; ni < NI; ++ni) acc[mi][ni] = __builtin_amdgcn_mfma_f32_16x16x32_bf16(wf[ks][ni], xf[ks][mi], acc[mi][ni], 0, 0, 0);
  }
}

template <int NI>
__device__ __forceinline__ void zero_acc(f32x4 (&acc)[4][NI]) {
#pragma unroll
  for (int i = 0; i < 4; ++i)
#pragma unroll
    for (int j = 0; j < NI; ++j) acc[i][j] = (f32x4){0.f, 0.f, 0.f, 0.f};
}
__device__ __forceinline__ int xcd_tile(int r, int nN, int& mt, int& nt) {
  const int G8 = gridDim.x >> 3, x = blockIdx.x & 7, slot = blockIdx.x >> 3;
  const int per = 8 * nN, total = 4 * per, nfull = nN >> 2;
  const int L = r * G8 + slot;
  if (L >= total) return -1;
  const int sbm = L / per, Lin = L - sbm * per;
  int sbn, within;
  if (Lin < 32 * nfull) { sbn = Lin >> 5; within = Lin & 31; }
  else { sbn = nfull; within = Lin - 32 * nfull; }
  mt = 32 * x + 8 * sbm + (within & 7); nt = 4 * sbn + (within >> 3);
  return 1;
}
__device__ __forceinline__ void tile_of(int id, int nN, int& mt, int& nt) {
  const int per = 8 * nN; const int g = id / per, rem = id % per;
  mt = g * 8 + (rem & 7); nt = rem >> 3;
}

__device__ __forceinline__ bool next_valid(int& rr, int nN, int& mt, int& nt) {
  for (;;) { const int st = xcd_tile(rr, nN, mt, nt); ++rr; if (st < 0) return false; if (st > 0) return true; }
}
__device__ __forceinline__ void phase_ffn_up(const bf16_t* U, const bf16_t* Wgu, bf16_t* H, unsigned char* smem) {
  const int lane = TIDX & 63, w = WAVE, wr = w >> 1, wc = w & 1, fr = lane & 15, fq = lane >> 4;
  const int nN = 5632 / 128, ntiles = (MTOK / 128) * nN;
  int rr = 0, mt, nt, mt2 = 0, nt2 = 0;
  bool have = next_valid(rr, nN, mt, nt), pre = false;
  for (; have; mt = mt2, nt = nt2) {
    const bool have2 = next_valid(rr, nN, mt2, nt2);
    f32x4 acc[4][4]; zero_acc(acc);
    gemm_mainloop<0, 4>(acc, U, DM, 64, Wgu, DM, DM, mt * 128, nt * 128, smem, pre, have2 ? mt2 * 128 : -1, nt2 * 128);
    pre = have2; have = have2;
    const int hb = (nt * 128 + wc * 64) >> 1;
#pragma unroll
    for (int mi = 0; mi < 4; ++mi) {
      const int m = mt * 128 + wr * 64 + 16 * mi + fr;
#pragma unroll
      for (int np = 0; np < 2; ++np) {
        const f32x4 g = acc[mi][2 * np], u = acc[mi][2 * np + 1];
        u32x2 o; o.x = pack2(siluf_(g[0]) * u[0], siluf_(g[1]) * u[1]); o.y = pack2(siluf_(g[2]) * u[2], siluf_(g[3]) * u[3]);
        *(u32x2*)(H + (size_t)m * DFF + hb + 16 * np + 4 * fq) = o;
      }
    }
  }
}


__device__ __forceinline__ int swz32(int row, int chunk) { return row * 64 + ((chunk ^ ((0x1320 >> (((row >> 2) & 3) * 4)) & 3)) << 4); }
__device__ __forceinline__ void gemm_wide(f32x4 (&acc)[4][8], const bf16_t* __restrict__ A, long lda, const bf16_t* __restrict__ Bp,
                                          int K, int m0, int n0, unsigned char* smem, bool pre, int nm0, int nn0) {
  const int lane = TIDX & 63, w = WAVE, wr = w >> 1, wc = w & 1, fr = lane & 15, fq = lane >> 4;
  const int lr = lane >> 2, ph = lane & 3;
  const int kb32 = K >> 5;
  const bf16_t* ap[2]; const bf16_t* bp[4];
#pragma unroll
  for (int j = 0; j < 2; ++j) {
    const int row = w * 32 + j * 16 + lr, c = ph ^ ((0x1320 >> (((row >> 2) & 3) * 4)) & 3);
    ap[j] = A + (size_t)(m0 + row) * lda + c * 8;
  }
#pragma unroll
  for (int j = 0; j < 4; ++j) bp[j] = Bp + (size_t)((n0 + w * 64 + j * 16) >> 4) * kb32 * 512 + lane * 8;
  unsigned char* As = smem; unsigned char* Bs = smem + 16384;
  const int a_l = (w * 32) * 64 + lane * 16, b_l = (w * 64) * 64 + lane * 16;
  const int nk = kb32;
  auto issue = [&](int kt, int buf, long da, long db) {
#pragma unroll
    for (int j = 0; j < 2; ++j)
      __builtin_amdgcn_global_load_lds((const unsigned*)(ap[j] + da + (size_t)kt * 32), (LDS_AS unsigned*)(As + buf * 8192 + a_l + j * 1024), 16, 0, 0);
#pragma unroll
    for (int j = 0; j < 4; ++j)
      __builtin_amdgcn_global_load_lds((const unsigned*)(bp[j] + db + (size_t)kt * 512), (LDS_AS unsigned*)(Bs + buf * 16384 + b_l + j * 1024), 16, 0, 0);
  };
  if (!pre) {
    __syncthreads();
    issue(0, 0, 0, 0);
  }
  for (int kt = 0; kt < nk; ++kt) {
    const int cur = kt & 1;
    __syncthreads();
    const unsigned char* a_s = As + cur * 8192; const unsigned char* b_s = Bs + cur * 16384;
    bf16x8 xf[4], wf[8];
#pragma unroll
    for (int i = 0; i < 4; ++i) xf[i] = *(const bf16x8*)(a_s + swz32(wr * 64 + 16 * i + fr, fq));
#pragma unroll
    for (int i = 0; i < 8; ++i) wf[i] = *(const bf16x8*)(b_s + swz32(wc * 128 + 16 * i + fr, fq));
    if (kt + 1 < nk) issue(kt + 1, cur ^ 1, 0, 0);
    else if (nm0 >= 0) issue(0, 0, (long)(nm0 - m0) * lda, (long)((nn0 - n0) >> 4) * kb32 * 512);
#pragma unroll
    for (int mi = 0; mi < 4; ++mi)
#pragma unroll
      for (int ni = 0; ni < 8; ++ni) acc[mi][ni] = __builtin_amdgcn_mfma_f32_16x16x32_bf16(wf[ni], xf[mi], acc[mi][ni], 0, 0, 0);
  }
}

__device__ __forceinline__ void phase_ffn_up_wide(const bf16_t* U, const bf16_t* Wgu, bf16_t* H, unsigned char* smem) {
  const int lane = TIDX & 63, w = WAVE, wr = w >> 1, wc = w & 1, fr = lane & 15, fq = lane >> 4;
  const int nN = 5632 / 256;
  int rr = 0, mt, nt, mt2 = 0, nt2 = 0;
  bool have = next_valid(rr, nN, mt, nt), pre = false;
  for (; have; mt = mt2, nt = nt2) {
    const bool have2 = next_valid(rr, nN, mt2, nt2);
    f32x4 acc[4][8];
#pragma unroll
    for (int i = 0; i < 4; ++i)
#pragma unroll
      for (int j = 0; j < 8; ++j) acc[i][j] = (f32x4){0.f, 0.f, 0.f, 0.f};
    gemm_wide(acc, U, DM, Wgu, DM, mt * 128, nt * 256, smem, pre, have2 ? mt2 * 128 : -1, nt2 * 256);
    pre = have2; have = have2;
    const int hb = (nt * 256 + wc * 128) >> 1;
#pragma unroll
    for (int mi = 0; mi < 4; ++mi) {
      const int m = mt * 128 + wr * 64 + 16 * mi + fr;
#pragma unroll
      for (int np = 0; np < 4; ++np) {
        const f32x4 g = acc[mi][2 * np], u = acc[mi][2 * np + 1];
        u32x2 o; o.x = pack2(siluf_(g[0]) * u[0], siluf_(g[1]) * u[1]); o.y = pack2(siluf_(g[2]) * u[2], siluf_(g[3]) * u[3]);
        *(u32x2*)(H + (size_t)m * DFF + hb + 16 * np + 4 * fq) = o;
      }
    }
  }
}

__device__ __forceinline__ void phase_gemm_resid(const bf16_t* A, long lda, const bf16_t* Bt, int K, const float* xsrc, float* out, float scale, unsigned char* smem) {
  const int lane = TIDX & 63, w = WAVE, wr = w >> 1, wc = w & 1, fr = lane & 15, fq = lane >> 4;
  const int nN = DM / 128, ntiles = (MTOK / 128) * nN;
  int rr = 0, mt, nt, mt2 = 0, nt2 = 0;
  bool have = next_valid(rr, nN, mt, nt), pre = false;
  for (; have; mt = mt2, nt = nt2) {
    const bool have2 = next_valid(rr, nN, mt2, nt2);
    f32x4 acc[4][4]; zero_acc(acc);
    gemm_mainloop<0, 4>(acc, A, lda, 64, Bt, K, K, mt * 128, nt * 128, smem, pre, have2 ? mt2 * 128 : -1, nt2 * 128);
    pre = have2; have = have2;
#pragma unroll
    for (int mi = 0; mi < 4; ++mi) {
      const int m = mt * 128 + wr * 64 + 16 * mi + fr;
#pragma unroll
      for (int ni = 0; ni < 4; ++ni) {
        const size_t o = (size_t)m * DM + nt * 128 + wc * 64 + 16 * ni + 4 * fq;
        f32x4 xv = *(const f32x4*)(xsrc + o);
        xv = xv + acc[mi][ni] * scale;
        *(f32x4*)(out + o) = xv;
      }
    }
  }
}


__device__ __forceinline__ void phase_gemm_resid_wide(const bf16_t* A, long lda, const bf16_t* Bp, int K, const float* xsrc, float* out, float scale, unsigned char* smem) {
  const int lane = TIDX & 63, w = WAVE, wr = w >> 1, wc = w & 1, fr = lane & 15, fq = lane >> 4;
  const int nN = DM / 256;
  int rr = 0, mt, nt, mt2 = 0, nt2 = 0;
  bool have = next_valid(rr, nN, mt, nt), pre = false;
  for (; have; mt = mt2, nt = nt2) {
    const bool have2 = next_valid(rr, nN, mt2, nt2);
    f32x4 acc[4][8];
#pragma unroll
    for (int i = 0; i < 4; ++i)
#pragma unroll
      for (int j = 0; j < 8; ++j) acc[i][j] = (f32x4){0.f, 0.f, 0.f, 0.f};
    gemm_wide(acc, A, lda, Bp, K, mt * 128, nt * 256, smem, pre, have2 ? mt2 * 128 : -1, nt2 * 256);
    pre = have2; have = have2;
#pragma unroll
    for (int mi = 0; mi < 4; ++mi) {
      const int m = mt * 128 + wr * 64 + 16 * mi + fr;
#pragma unroll
      for (int ni = 0; ni < 8; ++ni) {
        const size_t o = (size_t)m * DM + nt * 256 + wc * 128 + 16 * ni + 4 * fq;
        f32x4 xv = *(const f32x4*)(xsrc + o);
        xv = xv + acc[mi][ni] * scale;
        *(f32x4*)(out + o) = xv;
      }
    }
  }
}

template <int NIT, int OFF>
__device__ __forceinline__ void proj_epi(const Params& p, int l, f32x4 (&acc)[4][NIT], int mrow0, int nb, int fr, int fq) {
  bf16_t* P = (bf16_t*)(p.ws + OFF_P);
  const float2* rope = (const float2*)(p.ws + OFF_ROPE);
  const int cidx = nb >> 6;
  int type = 0; const float* gain = nullptr; float scale = 1.f;
  if (cidx < 8) { type = 1; gain = p.in[I_SWAQG] + l * 64; scale = 0.125f * 1.4426950408889634f; }
  else if (cidx < 10) { type = 1; gain = p.in[I_SWAKG] + l * 64; }
  else if (cidx >= 36 && cidx < 44) { type = 1; gain = p.in[I_NSAQG] + l * 64; scale = 0.125f * 1.4426950408889634f; }
  else if (cidx == 48 || cidx == 49) { type = 1; gain = p.in[I_NSAKG] + l * 192 + 64; }
  else if (cidx == 52 || cidx == 53) { type = 1; gain = p.in[I_NSAKG] + l * 192 + 128; }
  else if (cidx >= 58 && cidx < 62) { type = 2; }
  else if (cidx >= 62 && cidx < 66) { type = 2; scale = 0.125f; }
  if (type == 1) {
    f32x4 gv[4];
#pragma unroll
    for (int ni = 0; ni < 4; ++ni) gv[ni] = *(const f32x4*)(gain + 16 * ni + 4 * fq) * scale;
#pragma unroll
    for (int mi = 0; mi < 4; ++mi) {
      float ss = 0.f;
#pragma unroll
      for (int ni = 0; ni < 4; ++ni) { const f32x4 a = acc[mi][OFF + ni]; ss += a[0] * a[0] + a[1] * a[1] + a[2] * a[2] + a[3] * a[3]; }
      ss += __shfl_xor(ss, 16); ss += __shfl_xor(ss, 32);
      const float rs = rsqrtf(ss * (1.f / 64.f) + 1e-6f);
#pragma unroll
      for (int ni = 0; ni < 4; ++ni) acc[mi][OFF + ni] = acc[mi][OFF + ni] * rs * gv[ni];
    }
  } else if (type == 2) {
#pragma unroll
    for (int mi = 0; mi < 4; ++mi) {
      const int m = mrow0 + 16 * mi + fr, pos = m & (T_SEQ - 1);
#pragma unroll
      for (int ni = 0; ni < 2; ++ni) {
        const float2* tp = rope + pos * 32 + 16 * ni + 4 * fq;
#pragma unroll
        for (int r = 0; r < 4; ++r) {
          const float2 cs = tp[r];
          const float x1 = acc[mi][OFF + ni][r], x2 = acc[mi][OFF + ni + 2][r];
          acc[mi][OFF + ni][r] = (x1 * cs.x - x2 * cs.y) * scale;
          acc[mi][OFF + ni + 2][r] = (x1 * cs.y + x2 * cs.x) * scale;
        }
      }
    }
  }
#pragma unroll
  for (int mi = 0; mi < 4; ++mi) {
    const int m = mrow0 + 16 * mi + fr;
#pragma unroll
    for (int ni = 0; ni < 4; ++ni) {
      u32x2 o; o.x = pack2(acc[mi][OFF + ni][0], acc[mi][OFF + ni][1]); o.y = pack2(acc[mi][OFF + ni][2], acc[mi][OFF + ni][3]);
      *(u32x2*)(P + (size_t)m * LDP + nb + 16 * ni + 4 * fq) = o;
    }
  }
}

__device__ __forceinline__ void phase_proj(const Params& p, int l, unsigned char* smem) {
  const int lane = TIDX & 63, w = WAVE, wr = w >> 1, wc = w & 1, fr = lane & 15, fq = lane >> 4;
  const bf16_t* U = (const bf16_t*)(p.ws + OFF_U);
  const bf16_t* W = (const bf16_t*)(p.ws + OFF_WIN);
  {
    const int nN = 20;
    int rr = 0, mt, nt, mt2 = 0, nt2 = 0;
    bool have = next_valid(rr, nN, mt, nt), pre = false;
    for (; have; mt = mt2, nt = nt2) {
      const bool have2 = next_valid(rr, nN, mt2, nt2);
      f32x4 acc[4][8];
#pragma unroll
      for (int i = 0; i < 4; ++i)
#pragma unroll
        for (int j = 0; j < 8; ++j) acc[i][j] = (f32x4){0.f, 0.f, 0.f, 0.f};
      gemm_wide(acc, U, DM, W, DM, mt * 128, nt * 256, smem, pre, have2 ? mt2 * 128 : -1, nt2 * 256);
      pre = have2; have = have2;
      proj_epi<8, 0>(p, l, acc, mt * 128 + wr * 64, nt * 256 + wc * 128, fr, fq);
      proj_epi<8, 4>(p, l, acc, mt * 128 + wr * 64, nt * 256 + wc * 128 + 64, fr, fq);
    }
  }
  {
    const int nN = 1;
    int rr = 0, mt, nt, mt2 = 0, nt2 = 0;
    bool have = next_valid(rr, nN, mt, nt), pre = false;
    for (; have; mt = mt2, nt = nt2) {
      const bool have2 = next_valid(rr, nN, mt2, nt2);
      f32x4 acc[4][4]; zero_acc(acc);
      gemm_mainloop<0, 4>(acc, U, DM, 64, W + (size_t)5120 * DM, DM, DM, mt * 128, 0, smem, pre, have2 ? mt2 * 128 : -1, 0);
      pre = have2; have = have2;
      proj_epi<4, 0>(p, l, acc, mt * 128 + wr * 64, 5120 + wc * 64, fr, fq);
    }
  }
}

__device__ __forceinline__ void compress_gemm1_tile(const Params& p, int id, unsigned char* smem) {
  const int lane = TIDX & 63, w = WAVE, wr = w >> 1, wc = w & 1, fr = lane & 15, fq = lane >> 4;
  const int kv = id >> 6, rem = id & 63, mt = rem >> 1, nt = rem & 1;
  const bf16_t* P = (const bf16_t*)(p.ws + OFF_P);
  const bf16_t* A = P + (kv ? C_CVC : C_CKC);
  const bf16_t* W = (const bf16_t*)(p.ws + (kv ? OFF_WCV1 : OFF_WCK1));
  const float* bias = (const float*)(p.ws + OFF_CB1) + kv * 256;
  bf16_t* H = (bf16_t*)(p.ws + OFF_CMPH) + (size_t)kv * 4096 * 256;
  f32x4 acc[4][4]; zero_acc(acc);
  gemm_mainloop<1, 4>(acc, A, LDP, LDP, W, 2048, 2048, mt * 128, nt * 128, smem);
#pragma unroll
  for (int mi = 0; mi < 4; ++mi) {
    const int m = mt * 128 + wr * 64 + 16 * mi + fr;
#pragma unroll
    for (int ni = 0; ni < 4; ++ni) {
      const int n = nt * 128 + wc * 64 + 16 * ni + 4 * fq;
      const f32x4 bv = *(const f32x4*)(bias + n);
      const f32x4 a = acc[mi][ni] + bv;
      u32x2 o; o.x = pack2(gelu_tanh(a[0]), gelu_tanh(a[1])); o.y = pack2(gelu_tanh(a[2]), gelu_tanh(a[3]));
      *(u32x2*)(H + (size_t)m * 256 + n) = o;
    }
  }
}

__device__ __forceinline__ void phase_merge(const Params& p, int l, unsigned char* smem) {
  const int lane = TIDX & 63, w = WAVE, wr = w >> 1, wc = w & 1, fr = lane & 15, fq = lane >> 4;
  const bf16_t* U = (const bf16_t*)(p.ws + OFF_U);
  bf16_t* P = (bf16_t*)(p.ws + OFF_P);
  const bf16_t* Wg = (const bf16_t*)(p.ws + OFF_WGATE);
  const bf16_t* Wb = (const bf16_t*)(p.ws + OFF_WBR);
  const float* bias = p.in[I_MGB] + (size_t)l * 4096;
  const int nN = DM / 128;
  for (int rr = 0;; ++rr) {
    int mt, nt; const int st = xcd_tile(rr, nN, mt, nt);
    if (st < 0) break;
    if (st == 0) continue;
    const int nb = nt * 128 + wc * 64;
    unsigned mrg[4][4][2];
#pragma unroll
    for (int mi = 0; mi < 4; ++mi)
#pragma unroll
      for (int ni = 0; ni < 4; ++ni) { mrg[mi][ni][0] = 0u; mrg[mi][ni][1] = 0u; }
    for (int i = 0; i < 4; ++i) {
      const int ycol = (i == 0) ? C_AQ : (i == 1) ? C_BB : (i == 2) ? C_CQ : C_DG;
      unsigned sg[4][4][2];
      {
        f32x4 acc[4][4]; zero_acc<4>(acc);
        gemm_mainloop<0, 4>(acc, U, DM, 64, Wg + (size_t)i * 1024 * 1024, DM, DM, mt * 128, nt * 128, smem);
#pragma unroll
        for (int ni = 0; ni < 4; ++ni) {
          const f32x4 bv = *(const f32x4*)(bias + i * 1024 + nb + 16 * ni + 4 * fq);
#pragma unroll
          for (int mi = 0; mi < 4; ++mi) {
            const f32x4 a = acc[mi][ni] + bv;
            sg[mi][ni][0] = pack2(sigmoidf_(a[0]), sigmoidf_(a[1]));
            sg[mi][ni][1] = pack2(sigmoidf_(a[2]), sigmoidf_(a[3]));
          }
        }
      }
      f32x4 acc[4][4]; zero_acc<4>(acc);
      gemm_mainloop<0, 4>(acc, P + ycol, LDP, 64, Wb + (size_t)i * 1024 * 512, 512, 512, mt * 128, nt * 128, smem);
#pragma unroll
      for (int mi = 0; mi < 4; ++mi)
#pragma unroll
        for (int ni = 0; ni < 4; ++ni) {
          f32x4 sv;
          sv[0] = __uint_as_float(sg[mi][ni][0] << 16); sv[1] = __uint_as_float(sg[mi][ni][0] & 0xffff0000u);
          sv[2] = __uint_as_float(sg[mi][ni][1] << 16); sv[3] = __uint_as_float(sg[mi][ni][1] & 0xffff0000u);
          const f32x4 t4 = sv * acc[mi][ni];
          const unsigned m0 = mrg[mi][ni][0], m1 = mrg[mi][ni][1];
          mrg[mi][ni][0] = pack2(__uint_as_float(m0 << 16) + t4[0], __uint_as_float(m0 & 0xffff0000u) + t4[1]);
          mrg[mi][ni][1] = pack2(__uint_as_float(m1 << 16) + t4[2], __uint_as_float(m1 & 0xffff0000u) + t4[3]);
        }
    }
#pragma unroll
    for (int mi = 0; mi < 4; ++mi) {
      const int m = mt * 128 + wr * 64 + 16 * mi + fr;
#pragma unroll
      for (int ni = 0; ni < 4; ++ni) {
        u32x2 o; o.x = mrg[mi][ni][0]; o.y = mrg[mi][ni][1];
        *(u32x2*)(P + (size_t)m * LDP + C_MERGED + nb + 16 * ni + 4 * fq) = o;
      }
    }
  }
}

#define MFMA32(a, b, c) __builtin_amdgcn_mfma_f32_32x32x16_bf16(a, b, c, 0, 0, 0)
constexpr int AL_K = 0;
constexpr int AL_VT = 8192;
constexpr int KVB = 16896;
constexpr int AL_IMP = 33792;
constexpr int AL_SEL = 66816;
constexpr int AL_UNI = 67840;
constexpr int VTS = 68;

union FragU { u32x4 u; bf16x8 b; };
typedef short v4i16_t __attribute__((ext_vector_type(4)));
__device__ __forceinline__ int vtr_lane_off(int lane) {
  const int g = lane >> 4, q = (lane & 15) >> 2, p = lane & 3, h = lane >> 5;
  return (4 * h + q) * 128 + ((4 * (q >> 1) + 2 * (g & 1) + (p >> 1)) << 4) + 8 * (p & 1);
}
__device__ __forceinline__ bf16x8 vtr_frag(const unsigned char* vimg, int loff, int dt, int mt, int s) {
  const unsigned char* a = vimg + ((loff ^ (dt << 6)) + (32 * mt + 16 * s) * 128);
  const v4i16_t lo = __builtin_amdgcn_ds_read_tr16_b64_v4i16((LDS_AS v4i16_t*)a);
  const v4i16_t hi = __builtin_amdgcn_ds_read_tr16_b64_v4i16((LDS_AS v4i16_t*)(a + 8 * 128));
  return (bf16x8){lo[0], lo[1], lo[2], lo[3], hi[0], hi[1], hi[2], hi[3]};
}
struct KVRegs { u32x4 k[2], v[2]; };

__device__ __forceinline__ void kv_load(KVRegs& R, const bf16_t* kbase, const bf16_t* vbase, long stride, int key0, bool want_v) {
  const int t = TIDX, c = t & 7, r0 = t >> 3;
#pragma unroll
  for (int i = 0; i < 2; ++i) {
    const size_t o = (size_t)(key0 + r0 + 32 * i) * stride + c * 8;
    R.k[i] = *(const u32x4*)(kbase + o);
    if (want_v) R.v[i] = *(const u32x4*)(vbase + o);
  }
}
__device__ __forceinline__ void kv_store(const KVRegs& R, unsigned char* smem, bool want_v) {
  const int t = TIDX, c = t & 7, r0 = t >> 3;
#pragma unroll
  for (int i = 0; i < 2; ++i) {
    const int row = r0 + 32 * i;
    *(u32x4*)(smem + AL_K + swz(row, c)) = R.k[i];
    if (want_v) *(u32x4*)(smem + AL_VT + row * 128 + ((c ^ (((row >> 1) & 1) << 2)) << 4)) = R.v[i];
  }
}
template <bool QL>
__device__ __forceinline__ void compute_S(const bf16x8 (&q)[4], int nt, f32x16 (&S)[2], const unsigned char* smem, int lane) {
  const int r = lane & 31, h = lane >> 5;
  const unsigned char* qp = smem + AL_IMP + WAVE * 8192 + nt * 4096 + lane * 16;
#pragma unroll
  for (int mt = 0; mt < 2; ++mt) {
#pragma unroll
    for (int i = 0; i < 16; ++i) S[mt][i] = 0.f;
#pragma unroll
    for (int ks = 0; ks < 4; ++ks) {
      const bf16x8 kf = *(const bf16x8*)(smem + AL_K + swz(32 * mt + r, 2 * ks + h));
      const bf16x8 qf = QL ? *(const bf16x8*)(qp + ks * 1024) : q[ks];
      S[mt] = MFMA32(kf, qf, S[mt]);
    }
  }
}
__device__ __forceinline__ void park_q(const bf16x8 (&q)[2][4], unsigned char* smem, int lane) {
  unsigned char* qp = smem + AL_IMP + WAVE * 8192 + lane * 16;
#pragma unroll
  for (int nt = 0; nt < 2; ++nt)
#pragma unroll
    for (int ks = 0; ks < 4; ++ks) *(bf16x8*)(qp + nt * 4096 + ks * 1024) = q[nt][ks];
}
template <int MODE, bool QL>
__device__ __forceinline__ void attn_tile_online(const bf16x8 (&q)[2][4], f32x16 (&O)[2][2], float (&m)[2], float (&l)[2],
                                                 const unsigned char* smem, const unsigned char* kvb, int kv0, int q0, int lane, unsigned selw, bool needmask) {
  const int r = lane & 31, h = lane >> 5;
  const int vloff = vtr_lane_off(lane);
  bool sel[2]; float negm[2];
#pragma unroll
  for (int nt = 0; nt < 2; ++nt) { sel[nt] = (MODE != 2) || ((selw >> nt) & 1u); negm[nt] = (MODE == 2 && !sel[nt]) ? -1e30f : -m[nt]; }
  f32x16 S[2][2];
#pragma unroll
  for (int nt = 0; nt < 2; ++nt)
#pragma unroll
    for (int mt = 0; mt < 2; ++mt)
#pragma unroll
      for (int i = 0; i < 16; ++i) S[nt][mt][i] = negm[nt];
#pragma unroll
  for (int ks = 0; ks < 4; ++ks)
#pragma unroll
    for (int mt = 0; mt < 2; ++mt) {
      const bf16x8 kf = *(const bf16x8*)(kvb + AL_K + swz(32 * mt + r, 2 * ks + h));
#pragma unroll
      for (int nt = 0; nt < 2; ++nt) S[nt][mt] = MFMA32(kf, q[nt][ks], S[nt][mt]);
    }
  if (needmask) {
#pragma unroll
    for (int nt = 0; nt < 2; ++nt)
#pragma unroll
      for (int mt = 0; mt < 2; ++mt) {
        const int dq = q0 + 32 * nt + r - kv0 - 4 * h - 32 * mt;
#pragma unroll
        for (int i = 0; i < 16; ++i) {
          const int cst = (i & 3) + 8 * (i >> 2);
          bool valid;
          if (MODE == 0) valid = (cst <= dq) && (cst > dq - 128);
          else if (MODE == 1) valid = (cst <= dq) && (cst > dq - 512);
          else valid = (cst <= dq);
          S[nt][mt][i] = valid ? S[nt][mt][i] : -INFINITY;
        }
      }
  }
  float mx[2];
#pragma unroll
  for (int nt = 0; nt < 2; ++nt) {
    mx[nt] = -INFINITY;
#pragma unroll
    for (int mt = 0; mt < 2; ++mt) {
      const float a0 = fmaxf(fmaxf(fmaxf(S[nt][mt][0], S[nt][mt][1]), fmaxf(S[nt][mt][2], S[nt][mt][3])), fmaxf(fmaxf(S[nt][mt][4], S[nt][mt][5]), fmaxf(S[nt][mt][6], S[nt][mt][7])));
      const float a1 = fmaxf(fmaxf(fmaxf(S[nt][mt][8], S[nt][mt][9]), fmaxf(S[nt][mt][10], S[nt][mt][11])), fmaxf(fmaxf(S[nt][mt][12], S[nt][mt][13]), fmaxf(S[nt][mt][14], S[nt][mt][15])));
      mx[nt] = fmaxf(mx[nt], fmaxf(a0, a1));
    }
  }
  mx[0] = fmaxf(mx[0], __shfl_xor(mx[0], 32)); mx[1] = fmaxf(mx[1], __shfl_xor(mx[1], 32));
  if (__builtin_amdgcn_ballot_w64(fmaxf(mx[0], mx[1]) > 8.0f) != 0ull) {
#pragma unroll
    for (int nt = 0; nt < 2; ++nt) {
      const float d = (mx[nt] > 8.0f) ? mx[nt] : 0.f;
      const float alpha = __builtin_amdgcn_exp2f(-d);
      m[nt] += d; l[nt] *= alpha;
#pragma unroll
      for (int dt = 0; dt < 2; ++dt) O[nt][dt] = O[nt][dt] * alpha;
#pragma unroll
      for (int mt = 0; mt < 2; ++mt)
#pragma unroll
        for (int i = 0; i < 16; ++i) S[nt][mt][i] -= d;
    }
  }
#pragma unroll
  for (int nt = 0; nt < 2; ++nt) {
    float lsum = 0.f;
#pragma unroll
    for (int mt = 0; mt < 2; ++mt)
#pragma unroll
      for (int i = 0; i < 16; ++i) { const float pp = __builtin_amdgcn_exp2f(S[nt][mt][i]); S[nt][mt][i] = pp; lsum += pp; }
    l[nt] += lsum;
  }
#pragma unroll
  for (int mt = 0; mt < 2; ++mt)
#pragma unroll
    for (int s = 0; s < 2; ++s) {
      FragU pf[2];
#pragma unroll
      for (int nt = 0; nt < 2; ++nt) {
        pf[nt].u.x = pack2(S[nt][mt][8 * s + 0], S[nt][mt][8 * s + 1]); pf[nt].u.y = pack2(S[nt][mt][8 * s + 2], S[nt][mt][8 * s + 3]);
        pf[nt].u.z = pack2(S[nt][mt][8 * s + 4], S[nt][mt][8 * s + 5]); pf[nt].u.w = pack2(S[nt][mt][8 * s + 6], S[nt][mt][8 * s + 7]);
      }
#pragma unroll
      for (int dt = 0; dt < 2; ++dt) {
        const bf16x8 vf = vtr_frag(kvb + AL_VT, vloff, dt, mt, s);
#pragma unroll
        for (int nt = 0; nt < 2; ++nt) O[nt][dt] = MFMA32(vf, pf[nt].b, O[nt][dt]);
      }
    }
}

__device__ __forceinline__ void load_q(bf16x8 (&q)[2][4], const bf16_t* qbase  , int lane) {
  const int r = lane & 31, h = lane >> 5;
#pragma unroll
  for (int nt = 0; nt < 2; ++nt)
#pragma unroll
    for (int ks = 0; ks < 4; ++ks) q[nt][ks] = *(const bf16x8*)(qbase + (size_t)(32 * nt + r) * LDP + 16 * ks + 8 * h);
}
__device__ __forceinline__ void zero_O(f32x16 (&O)[2][2]) {
#pragma unroll
  for (int a = 0; a < 2; ++a)
#pragma unroll
    for (int b = 0; b < 2; ++b)
#pragma unroll
      for (int i = 0; i < 16; ++i) O[a][b][i] = 0.f;
}

template <int MODE, bool QL>
__device__ __forceinline__ void attn_loop(const bf16x8 (&q)[2][4], f32x16 (&O)[2][2], float (&m)[2], float (&l)[2], unsigned char* smem,
                                          const bf16_t* kbase, const bf16_t* vbase, long stride, int t0, int t1, int q0, int lane) {
  unsigned uni[4] = {0xffffffffu, 0xffffffffu, 0xffffffffu, 0xffffffffu};
  if (MODE == 2) {
    const unsigned* up = (const unsigned*)(smem + AL_UNI);
    uni[0] = up[0]; uni[1] = up[1]; uni[2] = up[2]; uni[3] = up[3];
  }
  auto bit = [&](int t) -> bool {
    const unsigned wv = (t < 32) ? uni[0] : (t < 64) ? uni[1] : (t < 96) ? uni[2] : uni[3];
    return (wv >> (t & 31)) & 1u;
  };
  auto next_tile = [&](int t) -> int { if (MODE == 2) { while (t < t1 && !bit(t)) ++t; } return t; };
  auto run_tile = [&](int cur, const unsigned char* kvb) {
    unsigned selw = 0;
    if (MODE == 2) {
      const unsigned* sm = (const unsigned*)(smem + AL_SEL);
      const int r = lane & 31;
      selw = ((sm[r * 4 + (cur >> 5)] >> (cur & 31)) & 1u) | (((sm[(32 + r) * 4 + (cur >> 5)] >> (cur & 31)) & 1u) << 1);
    }
    const int qt_ = q0 >> 6;
    const bool needmask = (MODE == 0) ? (cur != qt_ - 1) : (MODE == 1) ? (cur == qt_ || cur == qt_ - 8) : (cur == qt_);
    attn_tile_online<MODE, QL>(q, O, m, l, smem, kvb, cur * 64, q0, lane, selw, needmask);
  };
  int nxt = next_tile(t0);
  KVRegs R;
  {
    if (nxt >= t1) return;
    kv_load(R, kbase, vbase, stride, nxt * 64, true);
    __syncthreads();
    kv_store(R, smem, true);
    int cur = nxt, bsel = 0;
    nxt = next_tile(cur + 1);
    if (nxt < t1) kv_load(R, kbase, vbase, stride, nxt * 64, true);
    __syncthreads();
    for (;;) {
      run_tile(cur, smem + bsel * KVB);
      if (nxt >= t1) break;
      kv_store(R, smem + (bsel ^ 1) * KVB, true);
      cur = nxt;
      nxt = next_tile(cur + 1);
      if (nxt < t1) kv_load(R, kbase, vbase, stride, nxt * 64, true);
      __syncthreads();
      bsel ^= 1;
    }
  }
}

template <bool FIRST>
__device__ __forceinline__ void y_accum(bf16_t* ybase_in  , const f32x16 (&O)[2][2], const float (&sc)[2], int lane_in) {
  int lane = lane_in; asm volatile("" : "+v"(lane));
  bf16_t* ybase = ybase_in;
  const int r = lane & 31, h = lane >> 5;
#pragma unroll
  for (int nt = 0; nt < 2; ++nt)
#pragma unroll
    for (int dt = 0; dt < 2; ++dt)
#pragma unroll
      for (int g4 = 0; g4 < 4; ++g4) {
        u32x2* ptr = (u32x2*)(ybase + (size_t)(32 * nt + r) * LDP + 32 * dt + 8 * g4 + 4 * h);
        float v0 = O[nt][dt][4 * g4] * sc[nt], v1 = O[nt][dt][4 * g4 + 1] * sc[nt], v2 = O[nt][dt][4 * g4 + 2] * sc[nt], v3 = O[nt][dt][4 * g4 + 3] * sc[nt];
        if (!FIRST) {
          const u32x2 old = *ptr;
          v0 += __uint_as_float(old.x << 16); v1 += __uint_as_float(old.x & 0xffff0000u);
          v2 += __uint_as_float(old.y << 16); v3 += __uint_as_float(old.y & 0xffff0000u);
        }
        u32x2 o; o.x = pack2(v0, v1); o.y = pack2(v2, v3);
        *ptr = o;
      }
}

__device__ __forceinline__ void swa_unit(const Params& p, int l, int unit, unsigned char* smem) {
  const int lane = TIDX & 63, w = WAVE;
  const int qt = unit & 127, bg = unit >> 7, b = bg >> 1, g = bg & 1, head = g * 4 + w, q0 = qt * 64;
  bf16_t* P = (bf16_t*)(p.ws + OFF_P);
  bf16_t* rowb = P + (size_t)b * T_SEQ * LDP;
  bf16x8 q[2][4];
  load_q(q, rowb + (size_t)q0 * LDP + C_AQ + head * 64, lane);
  f32x16 O[2][2]; zero_O(O);
  float m[2] = {0.f, 0.f}, lsum[2] = {0.f, 0.f};
  const int t0 = (q0 >= 128) ? (q0 - 128) / 64 : 0, t1 = qt + 1;
  attn_loop<0, false>(q, O, m, lsum, smem, rowb + C_AK + g * 64, rowb + C_AV + g * 64, LDP, t0, t1, q0, lane);
  const float sink = p.in[I_SINK][l * 8 + head] * 1.4426950408889634f;
  float sc[2];
#pragma unroll
  for (int nt = 0; nt < 2; ++nt) {
    const float lt = lsum[nt] + __shfl_xor(lsum[nt], 32);
    const float mf = fmaxf(m[nt], sink);
    const float e = __builtin_amdgcn_exp2f(m[nt] - mf);
    const float den = lt * e + __builtin_amdgcn_exp2f(sink - mf);
    sc[nt] = e / fmaxf(den, 1e-30f);
  }
  y_accum<true>(rowb + (size_t)q0 * LDP + C_AQ + head * 64, O, sc, lane);
}

__device__ __forceinline__ int wave_max_i32(int v) {
  v = max(v, __builtin_amdgcn_update_dpp(v, v, 0x111, 0xf, 0xf, false));
  v = max(v, __builtin_amdgcn_update_dpp(v, v, 0x112, 0xf, 0xf, false));
  v = max(v, __builtin_amdgcn_update_dpp(v, v, 0x114, 0xf, 0xf, false));
  v = max(v, __builtin_amdgcn_update_dpp(v, v, 0x118, 0xf, 0xf, false));
  v = max(v, __builtin_amdgcn_update_dpp(v, v, 0x142, 0xa, 0xf, false));
  v = max(v, __builtin_amdgcn_update_dpp(v, v, 0x143, 0xc, 0xf, false));
  return __builtin_amdgcn_readlane(v, 63);
}
__device__ __forceinline__ void nsa_unit(const Params& p, int l, int unit, unsigned char* smem, int ycol = C_CQ) {
  const int lane = TIDX & 63, w = WAVE, r = lane & 31, h = lane >> 5;
  const int qt = 127 - (unit >> 3), bg = unit & 7, b = bg >> 1, g = bg & 1, head = g * 4 + w, q0 = qt * 64, cur = qt;
  bf16_t* P = (bf16_t*)(p.ws + OFF_P);
  bf16_t* rowb = P + (size_t)b * T_SEQ * LDP;
  const bf16_t* kcmp = (const bf16_t*)(p.ws + OFF_KCMP) + (size_t)bg * 512 * 64;
  const bf16_t* vcmp = (const bf16_t*)(p.ws + OFF_VCMP) + (size_t)bg * 512 * 64;
  bf16x8 q[2][4];
  load_q(q, rowb + (size_t)q0 * LDP + C_CQ + head * 64, lane);
  auto gate_of = [&](int i, int nt) -> float { int rr = r; asm volatile("" : "+v"(rr)); return sigmoidf_(bf2f(rowb[(size_t)(q0 + 32 * nt + rr) * LDP + C_CG + head * 3 + i])); };
  bf16_t* ybase = rowb + (size_t)q0 * LDP + ycol + head * 64;

  {
    unsigned* imp = (unsigned*)(smem + AL_IMP);
    for (int i = TIDX; i < 64 * 129; i += NTHREADS) imp[i] = 0u;
    unsigned* sm = (unsigned*)(smem + AL_SEL);
    for (int i = TIDX; i < 64 * 4 + 4; i += NTHREADS) sm[i] = 0u;
  }
  const int nmax = (q0 + 32) >> 4;
  const int nct = (nmax >> 6) + 1;
  const bool do_imp = (cur >= 16);
  float m[2] = {-1e30f, -1e30f}, ls[2] = {0.f, 0.f};
  {
    KVRegs R;
    kv_load(R, kcmp, vcmp, 64, 0, false);
    for (int t = 0; t < nct; ++t) {
      __syncthreads();
      kv_store(R, smem, false);
      __syncthreads();
      if (t + 1 < nct) kv_load(R, kcmp, vcmp, 64, (t + 1) * 64, false);
#pragma unroll
      for (int nt = 0; nt < 2; ++nt) {
        __builtin_amdgcn_sched_barrier(0);
        f32x16 S[2];
        compute_S<false>(q[nt], nt, S, smem, lane);
        __builtin_amdgcn_sched_barrier(0);
        const int tq = q0 + 32 * nt + r;
        float mx = -1e30f;
#pragma unroll
        for (int mt = 0; mt < 2; ++mt)
#pragma unroll
          for (int i = 0; i < 16; ++i) {
            const int dn = tq - 31 - 16 * (t * 64 + 32 * mt + 4 * h);
            const float sv = (16 * ((i & 3) + 8 * (i >> 2)) <= dn) ? S[mt][i] : -1e30f;
            S[mt][i] = sv; mx = fmaxf(mx, sv);
          }
        mx = fmaxf(mx, __shfl_xor(mx, 32));
        const float mnew = fmaxf(m[nt], mx);
        const float alpha = __builtin_amdgcn_exp2f(m[nt] - mnew);
        m[nt] = mnew;
        float s1 = 0.f;
#pragma unroll
        for (int mt = 0; mt < 2; ++mt)
#pragma unroll
          for (int i = 0; i < 16; ++i) s1 += (S[mt][i] > -1e29f) ? __builtin_amdgcn_exp2f(S[mt][i] - mnew) : 0.f;
        ls[nt] = ls[nt] * alpha + s1;
      }
    }
  }
  float rl[2];
#pragma unroll
  for (int nt = 0; nt < 2; ++nt) { const float lt = ls[nt] + __shfl_xor(ls[nt], 32); rl[nt] = 1.f / fmaxf(lt, 1e-30f); }
  {
    f32x16 O[2][2]; zero_O(O);
    KVRegs R;
    kv_load(R, kcmp, vcmp, 64, 0, true);
    for (int t = 0; t < nct; ++t) {
      __syncthreads();
      kv_store(R, smem, true);
      __syncthreads();
      if (t + 1 < nct) kv_load(R, kcmp, vcmp, 64, (t + 1) * 64, true);
#pragma unroll
      for (int nt = 0; nt < 2; ++nt) {
        const int tq = q0 + 32 * nt + r;
        const int vloff = vtr_lane_off(lane);
        unsigned* imp = (unsigned*)(smem + AL_IMP) + (32 * nt + r) * 129;
#pragma unroll
        for (int mt = 0; mt < 2; ++mt) {
          __builtin_amdgcn_sched_barrier(0);
          f32x16 S;
#pragma unroll
          for (int i = 0; i < 16; ++i) S[i] = 0.f;
#pragma unroll
          for (int ks = 0; ks < 4; ++ks) {
            const bf16x8 kf = *(const bf16x8*)(smem + AL_K + swz(32 * mt + r, 2 * ks + h));
            S = MFMA32(kf, q[nt][ks], S);
          }
          __builtin_amdgcn_sched_barrier(0);
#pragma unroll
          for (int i = 0; i < 16; ++i) {
            const int dn = tq - 31 - 16 * (t * 64 + 32 * mt + 4 * h);
            S[i] = (16 * ((i & 3) + 8 * (i >> 2)) <= dn) ? __builtin_amdgcn_exp2f(S[i] - m[nt]) * rl[nt] : 0.f;
          }
          if (do_imp) {
#pragma unroll
            for (int g4 = 0; g4 < 4; ++g4) {
              const int sb = (t * 64 + 32 * mt + 8 * g4 + 4 * h) >> 2;
              const float s4 = (S[4 * g4] + S[4 * g4 + 1]) + (S[4 * g4 + 2] + S[4 * g4 + 3]);
              atomicAdd(&imp[sb], (unsigned)(s4 * 16777216.f + 0.5f));
              if (sb + 1 < 128) atomicAdd(&imp[sb + 1], (unsigned)(S[4 * g4 + 3] * 16777216.f + 0.5f));
            }
          }
#pragma unroll
          for (int s2 = 0; s2 < 2; ++s2) {
            FragU pf;
            pf.u.x = pack2(S[8 * s2 + 0], S[8 * s2 + 1]); pf.u.y = pack2(S[8 * s2 + 2], S[8 * s2 + 3]);
            pf.u.z = pack2(S[8 * s2 + 4], S[8 * s2 + 5]); pf.u.w = pack2(S[8 * s2 + 6], S[8 * s2 + 7]);
#pragma unroll
            for (int dt = 0; dt < 2; ++dt) O[nt][dt] = MFMA32(vtr_frag(smem + AL_VT, vloff, dt, mt, s2), pf.b, O[nt][dt]);
          }
        }
      }
    }
    float sc[2] = {gate_of(0, 0), gate_of(0, 1)};
    y_accum<true>(ybase, O, sc, lane);
  }
  __syncthreads();
  {
    unsigned* sm = (unsigned*)(smem + AL_SEL);
    unsigned* un = (unsigned*)(smem + AL_UNI);
    const unsigned* imp = (const unsigned*)(smem + AL_IMP);
    for (int qi = 0; qi < 16; qi += 2) {
      unsigned mk[2][4];
      int v0[2], v1[2];
#pragma unroll
      for (int u = 0; u < 2; ++u) {
        const int qq = w * 16 + qi + u;
        mk[u][0] = mk[u][1] = mk[u][2] = mk[u][3] = 0u;
        if (!do_imp) {
          mk[u][0] = (cur >= 31) ? 0xffffffffu : ((1u << (cur + 1)) - 1u);
          v0[u] = v1[u] = -1;
        } else {
          v0[u] = (lane >= 1 && lane <= cur - 2) ? (int)imp[qq * 129 + lane] : -1;
          v1[u] = (lane + 64 <= cur - 2) ? (int)imp[qq * 129 + lane + 64] : -1;
          const int fs[3] = {0, cur - 1, cur};
#pragma unroll
          for (int k = 0; k < 3; ++k) {
            const int sb = fs[k];
            if (sb < 32) mk[u][0] |= 1u << sb; else if (sb < 64) mk[u][1] |= 1u << (sb - 32); else if (sb < 96) mk[u][2] |= 1u << (sb - 64); else mk[u][3] |= 1u << (sb - 96);
          }
        }
      }
      if (do_imp) {
        for (int rnd = 0; rnd < 13; ++rnd) {
          int mx[2];
#pragma unroll
          for (int u = 0; u < 2; ++u) mx[u] = wave_max_i32(max(v0[u], v1[u]));
#pragma unroll
          for (int u = 0; u < 2; ++u) {
            const unsigned long long b0 = __ballot(v0[u] == mx[u]);
            int sb;
            if (b0) { const int sl = __ffsll((long long)b0) - 1; sb = sl; if (lane == sl) v0[u] = -1; }
            else { const unsigned long long b1 = __ballot(v1[u] == mx[u]); const int sl = __ffsll((long long)b1) - 1; sb = sl + 64; if (lane == sl) v1[u] = -1; }
            if (sb < 32) mk[u][0] |= 1u << sb; else if (sb < 64) mk[u][1] |= 1u << (sb - 32); else if (sb < 96) mk[u][2] |= 1u << (sb - 64); else mk[u][3] |= 1u << (sb - 96);
          }
        }
      }
      if (lane == 0) {
#pragma unroll
        for (int u = 0; u < 2; ++u) {
          const int qq = w * 16 + qi + u;
          sm[qq * 4 + 0] = mk[u][0]; sm[qq * 4 + 1] = mk[u][1]; sm[qq * 4 + 2] = mk[u][2]; sm[qq * 4 + 3] = mk[u][3];
          atomicOr(&un[0], mk[u][0]); atomicOr(&un[1], mk[u][1]); atomicOr(&un[2], mk[u][2]); atomicOr(&un[3], mk[u][3]);
        }
      }
    }
  }
  __syncthreads();
  {
    f32x16 O[2][2]; zero_O(O);
    float m2[2] = {0.f, 0.f}, l2[2] = {0.f, 0.f};
    attn_loop<2, false>(q, O, m2, l2, smem, rowb + C_CKS + g * 64, rowb + C_CVS + g * 64, LDP, 0, cur + 1, q0, lane);
    float sc[2];
#pragma unroll
    for (int nt = 0; nt < 2; ++nt) { const float lt = l2[nt] + __shfl_xor(l2[nt], 32); sc[nt] = gate_of(1, nt) / fmaxf(lt, 1e-30f); }
    y_accum<false>(ybase, O, sc, lane);
  }
  {
    f32x16 O[2][2]; zero_O(O);
    float m2[2] = {0.f, 0.f}, l2[2] = {0.f, 0.f};
    const int t0 = (q0 >= 512) ? (q0 - 512) / 64 : 0;
    attn_loop<1, false>(q, O, m2, l2, smem, rowb + C_CKW + g * 64, rowb + C_CVW + g * 64, LDP, t0, cur + 1, q0, lane);
    float sc[2];
#pragma unroll
    for (int nt = 0; nt < 2; ++nt) { const float lt = l2[nt] + __shfl_xor(l2[nt], 32); sc[nt] = gate_of(2, nt) / fmaxf(lt, 1e-30f); }
    y_accum<false>(ybase, O, sc, lane);
  }
  __syncthreads();
}

__device__ __forceinline__ float ret_log2g(int h) { return log2f(1.f - exp2f(-5.f - (float)h)); }

__device__ __forceinline__ void ret_state_unit(const Params& p, int unit, unsigned char* smem) {
  const int t = TIDX, lane = t & 63, w = WAVE, r = lane & 31, hh = lane >> 5;
  const int n = unit & 63, bh = unit >> 6, b = bh >> 2, h = bh & 3;
  const bf16_t* P = (const bf16_t*)(p.ws + OFF_P);
  const bf16_t* rowb = P + ((size_t)b * T_SEQ + n * 128) * LDP;
  bf16_t* Vt = (bf16_t*)smem;
  bf16_t* Kt = (bf16_t*)(smem + 34816);
  const float l2g = ret_log2g(h);
  __syncthreads();
#pragma unroll
  for (int i = 0; i < 8; ++i) {
    const int idx = t + 256 * i, tok = idx >> 4, c = idx & 15;
    const u32x4 v = *(const u32x4*)(rowb + (size_t)tok * LDP + C_DV + h * 128 + c * 8);
#pragma unroll
    for (int j = 0; j < 4; ++j) {
      Vt[(8 * c + 2 * j) * 136 + tok] = (bf16_t)(v[j] & 0xffffu);
      Vt[(8 * c + 2 * j + 1) * 136 + tok] = (bf16_t)(v[j] >> 16);
    }
  }
#pragma unroll
  for (int i = 0; i < 4; ++i) {
    const int idx = t + 256 * i, tok = idx >> 3, c = idx & 7;
    const u32x4 v = *(const u32x4*)(rowb + (size_t)tok * LDP + C_DK + h * 64 + c * 8);
    const float z = exp2f((float)(127 - tok) * l2g);
#pragma unroll
    for (int j = 0; j < 4; ++j) {
      Kt[(8 * c + 2 * j) * 136 + tok] = f2bf(__uint_as_float(v[j] << 16) * z);
      Kt[(8 * c + 2 * j + 1) * 136 + tok] = f2bf(__uint_as_float(v[j] & 0xffff0000u) * z);
    }
  }
  __syncthreads();
  f32x16 acc[2];
#pragma unroll
  for (int ct = 0; ct < 2; ++ct)
#pragma unroll
    for (int i = 0; i < 16; ++i) acc[ct][i] = 0.f;
#pragma unroll
  for (int ks = 0; ks < 8; ++ks) {
    const bf16x8 a = *(const bf16x8*)(Vt + (32 * w + r) * 136 + 16 * ks + 8 * hh);
#pragma unroll
    for (int ct = 0; ct < 2; ++ct) {
      const bf16x8 bb = *(const bf16x8*)(Kt + (32 * ct + r) * 136 + 16 * ks + 8 * hh);
      acc[ct] = MFMA32(a, bb, acc[ct]);
    }
  }
  bf16_t* RT = (bf16_t*)(p.ws + OFF_RT) + ((size_t)bh * 64 + n) * 8192;
#pragma unroll
  for (int ct = 0; ct < 2; ++ct)
#pragma unroll
    for (int i = 0; i < 16; ++i) {
      const int dv = 32 * w + (i & 3) + 8 * (i >> 2) + 4 * hh;
      RT[dv * 64 + 32 * ct + r] = f2bf(acc[ct][i]);
    }
}

__device__ __forceinline__ void ret_scan(const Params& p) {
  bf16_t* RT = (bf16_t*)(p.ws + OFF_RT);
  for (int i = blockIdx.x * NTHREADS + TIDX; i < 16 * 8192; i += gridDim.x * NTHREADS) {
    const int bh = i >> 13, e = i & 8191, h = bh & 3;
    const float decay = exp2f(128.f * ret_log2g(h));
    bf16_t* ptr = RT + (size_t)bh * 64 * 8192 + e;
    float rr = 0.f;
    for (int n0 = 0; n0 < 64; n0 += 16) {
      float v[16];
#pragma unroll
      for (int j = 0; j < 16; ++j) v[j] = bf2f(ptr[(size_t)(n0 + j) * 8192]);
#pragma unroll
      for (int j = 0; j < 16; ++j) { ptr[(size_t)(n0 + j) * 8192] = f2bf(rr); rr = rr * decay + v[j]; }
    }
  }
}

__device__ __forceinline__ void ret_out_unit(const Params& p, int l, int unit, unsigned char* smem, int ocol = C_DG) {
  const int t = TIDX, lane = t & 63, w = WAVE, r = lane & 31, hh = lane >> 5;
  const int n = unit & 63, bh = unit >> 6, b = bh >> 2, h = bh & 3;
  bf16_t* P = (bf16_t*)(p.ws + OFF_P);
  bf16_t* rowb = P + ((size_t)b * T_SEQ + n * 128) * LDP;
  const bf16_t* RT = (const bf16_t*)(p.ws + OFF_RT) + ((size_t)bh * 64 + n) * 8192;
  unsigned char* Ks = smem;
  bf16_t* Vt = (bf16_t*)(smem + 16384);
  unsigned char* Rs = smem + 50176;
  const float l2g = ret_log2g(h);
  __syncthreads();
#pragma unroll
  for (int i = 0; i < 4; ++i) {
    const int idx = t + 256 * i, row = idx >> 3, c = idx & 7;
    *(u32x4*)(Ks + swz(row, c)) = *(const u32x4*)(rowb + (size_t)row * LDP + C_DK + h * 64 + c * 8);
    *(u32x4*)(Rs + swz(row, c)) = *(const u32x4*)(RT + row * 64 + c * 8);
  }
#pragma unroll
  for (int i = 0; i < 8; ++i) {
    const int idx = t + 256 * i, tok = idx >> 4, c = idx & 15;
    const u32x4 v = *(const u32x4*)(rowb + (size_t)tok * LDP + C_DV + h * 128 + c * 8);
#pragma unroll
    for (int j = 0; j < 4; ++j) {
      Vt[(8 * c + 2 * j) * 132 + tok] = (bf16_t)(v[j] & 0xffffu);
      Vt[(8 * c + 2 * j + 1) * 132 + tok] = (bf16_t)(v[j] >> 16);
    }
  }
  const int cq = 32 * w + r;
  bf16x8 qf[4];
#pragma unroll
  for (int ks = 0; ks < 4; ++ks) qf[ks] = *(const bf16x8*)(rowb + (size_t)cq * LDP + C_DQ + h * 64 + 16 * ks + 8 * hh);
  __syncthreads();
  f32x16 O[4];
#pragma unroll
  for (int dt = 0; dt < 4; ++dt) {
#pragma unroll
    for (int i = 0; i < 16; ++i) O[dt][i] = 0.f;
#pragma unroll
    for (int ks = 0; ks < 4; ++ks) {
      const bf16x8 a = *(const bf16x8*)(Rs + swz(32 * dt + r, 2 * ks + hh));
      O[dt] = MFMA32(a, qf[ks], O[dt]);
    }
  }
  const float xi = exp2f((float)(cq + 1) * l2g);
#pragma unroll
  for (int dt = 0; dt < 4; ++dt) O[dt] = O[dt] * xi;
  for (int mt = 0; mt <= w; ++mt) {
    f32x16 S;
#pragma unroll
    for (int i = 0; i < 16; ++i) S[i] = 0.f;
#pragma unroll
    for (int ks = 0; ks < 4; ++ks) {
      const bf16x8 a = *(const bf16x8*)(Ks + swz(32 * mt + r, 2 * ks + hh));
      S = MFMA32(a, qf[ks], S);
    }
    const int dbase = cq - 32 * mt - 4 * hh;
#pragma unroll
    for (int i = 0; i < 16; ++i) {
      const int d = dbase - ((i & 3) + 8 * (i >> 2));
      S[i] = (d >= 0) ? S[i] * exp2f((float)d * l2g) : 0.f;
    }
#pragma unroll
    for (int s = 0; s < 2; ++s) {
      FragU pf;
      pf.u.x = pack2(S[8 * s + 0], S[8 * s + 1]); pf.u.y = pack2(S[8 * s + 2], S[8 * s + 3]);
      pf.u.z = pack2(S[8 * s + 4], S[8 * s + 5]); pf.u.w = pack2(S[8 * s + 6], S[8 * s + 7]);
#pragma unroll
      for (int dt = 0; dt < 4; ++dt) {
        const bf16_t* a = Vt + (32 * dt + r) * 132 + 32 * mt + 16 * s + 4 * hh;
        const u32x2 lo = *(const u32x2*)a, hi = *(const u32x2*)(a + 8);
        FragU vf; vf.u.x = lo.x; vf.u.y = lo.y; vf.u.z = hi.x; vf.u.w = hi.y;
        O[dt] = MFMA32(vf.b, pf.b, O[dt]);
      }
    }
  }
  float s1 = 0.f;
#pragma unroll
  for (int dt = 0; dt < 4; ++dt)
#pragma unroll
    for (int i = 0; i < 16; ++i) s1 += O[dt][i];
  s1 += __shfl_xor(s1, 32);
  const float mu = s1 * (1.f / 128.f);
  float s2 = 0.f;
#pragma unroll
  for (int dt = 0; dt < 4; ++dt)
#pragma unroll
    for (int i = 0; i < 16; ++i) { const float d = O[dt][i] - mu; s2 += d * d; }
  s2 += __shfl_xor(s2, 32);
  const float rstd = rsqrtf(s2 * (1.f / 128.f) + 1e-6f);
  const float* gn = p.in[I_RETG] + (size_t)l * 512 + h * 128;
  bf16_t* yrow = rowb + (size_t)cq * LDP + C_DG + h * 128;
#pragma unroll
  for (int dt = 0; dt < 4; ++dt)
#pragma unroll
    for (int g4 = 0; g4 < 4; ++g4) {
      const int dv = 32 * dt + 8 * g4 + 4 * hh;
      const u32x2 gt = *(const u32x2*)(yrow + dv);
      const f32x4 gv = *(const f32x4*)(gn + dv);
      const float g0 = __uint_as_float(gt.x << 16), g1 = __uint_as_float(gt.x & 0xffff0000u);
      const float g2 = __uint_as_float(gt.y << 16), g3 = __uint_as_float(gt.y & 0xffff0000u);
      u32x2 o;
      o.x = pack2((O[dt][4 * g4 + 0] - mu) * rstd * gv[0] * siluf_(g0), (O[dt][4 * g4 + 1] - mu) * rstd * gv[1] * siluf_(g1));
      o.y = pack2((O[dt][4 * g4 + 2] - mu) * rstd * gv[2] * siluf_(g2), (O[dt][4 * g4 + 3] - mu) * rstd * gv[3] * siluf_(g3));
      *(u32x2*)(yrow + dv + (ocol - C_DG)) = o;
    }
}

__device__ __forceinline__ void conv_item(const Params& p, int l, int item) {
  bf16_t* P = (bf16_t*)(p.ws + OFF_P);
  const float* cw = p.in[I_CONVW] + (size_t)l * 1536;
  for (int k = TIDX; k < 32 * 64; k += NTHREADS) {
    const int tok = item * 32 + (k >> 6), c = k & 63, pos = tok & (T_SEQ - 1);
    const bf16_t* row = P + (size_t)tok * LDP;
    float z[3][8];
#pragma unroll
    for (int d = 0; d < 3; ++d) {
      if (pos >= d) {
        const u32x4 xv = *(const u32x4*)(row - (size_t)d * LDP + C_BX + c * 8);
        const u32x4 cv = *(const u32x4*)(row - (size_t)d * LDP + C_BC + c * 8);
#pragma unroll
        for (int j = 0; j < 4; ++j) {
          z[d][2 * j] = __uint_as_float(xv[j] << 16) * __uint_as_float(cv[j] << 16);
          z[d][2 * j + 1] = __uint_as_float(xv[j] & 0xffff0000u) * __uint_as_float(cv[j] & 0xffff0000u);
        }
      } else {
#pragma unroll
        for (int j = 0; j < 8; ++j) z[d][j] = 0.f;
      }
    }
    const u32x4 bv = *(const u32x4*)(row + C_BB + c * 8);
    float y[8];
#pragma unroll
    for (int j = 0; j < 8; ++j) {
      const int ch = c * 8 + j;
      const float bj = (j & 1) ? __uint_as_float(bv[j >> 1] & 0xffff0000u) : __uint_as_float(bv[j >> 1] << 16);
      y[j] = bj * (cw[ch] * z[2][j] + cw[512 + ch] * z[1][j] + cw[1024 + ch] * z[0][j]);
    }
    u32x4 o; o.x = pack2(y[0], y[1]); o.y = pack2(y[2], y[3]); o.z = pack2(y[4], y[5]); o.w = pack2(y[6], y[7]);
    *(u32x4*)(P + (size_t)tok * LDP + C_BB + c * 8) = o;
  }
}

__device__ __forceinline__ void compress2(const Params& p, int l) {
  const int lane = TIDX & 63;
  const int gw = blockIdx.x * 4 + WAVE, nw = gridDim.x * 4;
  for (int task = gw; task < 2048; task += nw) {
    const int kv = task >> 10, row0 = (task & 1023) * 4;
    const bf16_t* hid = (const bf16_t*)(p.ws + OFF_CMPH) + ((size_t)kv * 4096 + row0) * 256;
    const float* w2 = p.in[kv ? I_WV2 : I_WK2] + (size_t)l * 256 * 64;
    float acc[4] = {0.f, 0.f, 0.f, 0.f};
    for (int k8 = 0; k8 < 32; k8 += 2) {
      u32x4 hv[4][2]; float wv[16];
#pragma unroll
      for (int rr = 0; rr < 4; ++rr)
#pragma unroll
        for (int u = 0; u < 2; ++u) hv[rr][u] = *(const u32x4*)(hid + rr * 256 + (k8 + u) * 8);
#pragma unroll
      for (int u = 0; u < 16; ++u) wv[u] = w2[(k8 * 8 + u) * 64 + lane];
#pragma unroll
      for (int rr = 0; rr < 4; ++rr)
#pragma unroll
        for (int u = 0; u < 2; ++u)
#pragma unroll
          for (int j = 0; j < 4; ++j) {
            acc[rr] += __uint_as_float(hv[rr][u][j] << 16) * wv[u * 8 + 2 * j];
            acc[rr] += __uint_as_float(hv[rr][u][j] & 0xffff0000u) * wv[u * 8 + 2 * j + 1];
          }
    }
#pragma unroll
    for (int rr = 0; rr < 4; ++rr) {
      float a = acc[rr];
      if (kv == 0) {
        float ss = a * a;
#pragma unroll
        for (int o = 32; o >= 1; o >>= 1) ss += __shfl_xor(ss, o);
        a = a * rsqrtf(ss * (1.f / 64.f) + 1e-6f) * p.in[I_NSAKG][l * 192 + lane];
      }
      bf16_t* dst = (bf16_t*)(p.ws + (kv ? OFF_VCMP : OFF_KCMP)) + (size_t)(row0 + rr) * 64 + lane;
      *dst = f2bf(a);
    }
  }
}

#define XB_TMO      128
#define XB_XCNT(j)  (256  + 64 * (j))
#define XB_XSUB(j)  (1280 + 64 * (j))
#define XB_XGEN(j)  (2304 + 64 * (j))
#define XB_TOP      3328
#define XB_TOPGEN   3392
#define XCD_BAR_WORDS 3456
#define XB_SPIN_CAP (1u << 20)
__device__ __forceinline__ unsigned xb_ld(unsigned* p)              { return __hip_atomic_load(p, __ATOMIC_RELAXED, __HIP_MEMORY_SCOPE_AGENT); }
__device__ __forceinline__ unsigned xb_add(unsigned* p, unsigned v) { return __hip_atomic_fetch_add(p, v, __ATOMIC_RELAXED, __HIP_MEMORY_SCOPE_AGENT); }
__device__ __forceinline__ unsigned xb_xcc_id() { return (unsigned)__builtin_amdgcn_s_getreg((3 << 11) | 20) & 0xFu; }
#define XB_SPIN(cond, bar) do { unsigned _sp = 0; while (cond) { __builtin_amdgcn_s_sleep(1); \
    if ((++_sp & 255u) == 0u) { if (xb_ld(&(bar)[XB_TMO])) break; if (_sp > XB_SPIN_CAP) { atomicAdd(&(bar)[XB_TMO], 1u); break; } } } } while (0)
struct XcdBarrier { unsigned* bar; unsigned x; volatile LDS_AS unsigned* st; };
__device__ __forceinline__ XcdBarrier xcd_barrier_post(unsigned* bar, volatile LDS_AS unsigned* st) {
  XcdBarrier b; b.bar = bar; b.x = xb_xcc_id(); b.st = st;
  if (TIDX == 0) (void)xb_add(&bar[XB_XCNT(b.x)], 1u);
  return b;
}
__device__ __forceinline__ void xcd_barrier_complete(unsigned* bar, unsigned x, unsigned& nloc, unsigned& nx) {
  const unsigned G = gridDim.x * gridDim.y * gridDim.z;
  unsigned sum, cnt, mine, sp = 0u;
  for (;;) {
    sum = 0u; cnt = 0u; mine = 0u;
#pragma unroll
    for (unsigned j = 0; j < 16; ++j) { const unsigned c = xb_ld(&bar[XB_XCNT(j)]); sum += c; cnt += (c > 0u) ? 1u : 0u; mine = (j == x) ? c : mine; }
    if (sum == G) break;
    __builtin_amdgcn_s_sleep(1);
    if ((++sp & 255u) == 0u) { if (xb_ld(&bar[XB_TMO])) break; if (sp > XB_SPIN_CAP) { atomicAdd(&bar[XB_TMO], 1u); break; } }
  }
  nloc = mine > 0u ? mine : 1u; nx = cnt > 0u ? cnt : 1u;
}
__device__ __forceinline__ void xcd_barrier(const XcdBarrier& b) {
  asm volatile("s_waitcnt vmcnt(0)" ::: "memory");
  __syncthreads();
  if (TIDX == 0) {
    unsigned* bar = b.bar;
    __builtin_amdgcn_s_waitcnt(0);
    unsigned nloc = b.st[0], nx = b.st[1];
    if (nloc == 0u) { xcd_barrier_complete(bar, b.x, nloc, nx); b.st[0] = nloc; b.st[1] = nx; }
    const unsigned old = xb_add(&bar[XB_XSUB(b.x)], 1u);
    const unsigned gen = old / nloc;
    if (old + 1u == (gen + 1u) * nloc) {
      __builtin_amdgcn_fence(__ATOMIC_RELEASE, "agent");
      asm volatile("s_waitcnt vmcnt(0)" ::: "memory");
      const unsigned og = xb_add(&bar[XB_TOP], 1u);
      const unsigned tg = og / nx;
      if (og + 1u == (tg + 1u) * nx) xb_add(&bar[XB_TOPGEN], 1u);
      else XB_SPIN(xb_ld(&bar[XB_TOPGEN]) == tg, bar);
      __builtin_amdgcn_fence(__ATOMIC_ACQUIRE, "agent");
      xb_add(&bar[XB_XGEN(b.x)], 1u);
      asm volatile("s_waitcnt vmcnt(0)" ::: "memory");
    } else {
      XB_SPIN(xb_ld(&bar[XB_XGEN(b.x)]) == gen, bar);
      __builtin_amdgcn_fence(__ATOMIC_ACQUIRE, "agent");
      asm volatile("s_waitcnt vmcnt(0)" ::: "memory");
    }
  }
  __syncthreads();
}

constexpr int PH_PER_LAYER = 14;
__device__ __forceinline__ void run_phase(const Params& p, int ph, unsigned char* smem) {
  const int l = ph / PH_PER_LAYER, k = ph % PH_PER_LAYER;
  unsigned char* ws = p.ws;
  bf16_t* U = (bf16_t*)(ws + OFF_U);
  bf16_t* P = (bf16_t*)(ws + OFF_P);
  const float* xcur = (l == 0) ? p.in[I_X] : p.out;
  switch (k) {
    case 0: phase_convert(p, l, smem); break;
    case 1: phase_norm(xcur, p.in[I_F1N] + l * DM, U); break;
    case 2: phase_ffn_up_wide(U, (const bf16_t*)(ws + OFF_WGU1), P, smem); break;
    case 3: phase_gemm_resid_wide(P, DFF, (const bf16_t*)(ws + OFF_WD1), DFF, xcur, p.out, 0.5f, smem); break;
    case 4: phase_norm(p.out, p.in[I_MIXN] + l * DM, U); break;
    case 5: phase_proj(p, l, smem); break;
    case 6: {
      const int nitems = 128 + 1024 + 1024 + 1024;
      for (int it = blockIdx.x; it < nitems; it += gridDim.x) {
        if (it < 128) compress_gemm1_tile(p, it, smem);
        else if (it < 128 + 1024) swa_unit(p, l, it - 128, smem);
        else if (it < 128 + 1024 + 1024) ret_state_unit(p, it - 1152, smem);
        else conv_item(p, l, it - 2176);
        __syncthreads();
      }
    } break;
    case 7: compress2(p, l); ret_scan(p); break;
    case 8: {
      const int G = gridDim.x;
#ifdef DRY_M3
      { int rnd2 = 0;
        for (int base = 0; base < 1024; base += G, ++rnd2) {
          const int it = base + ((rnd2 & 1) ? (G - 1 - (int)blockIdx.x) : (int)blockIdx.x);
          if (it < 1024) nsa_unit(p, l, it, smem, C_BX);
          __syncthreads();
        }
        for (int it = blockIdx.x; it < 1024; it += gridDim.x) { ret_out_unit(p, l, it, smem, C_BC); __syncthreads(); }
      }
#endif
      int rnd = 0;
      for (int base = 0; base < 1024; base += G, ++rnd) {
        const int it = base + ((rnd & 1) ? (G - 1 - (int)blockIdx.x) : (int)blockIdx.x);
        if (it < 1024) nsa_unit(p, l, it, smem);
        __syncthreads();
      }
      for (int it = blockIdx.x; it < 1024; it += gridDim.x) {
        ret_out_unit(p, l, it, smem);
        __syncthreads();
      }
    } break;
    case 9: phase_merge(p, l, smem); break;
    case 10: phase_gemm_resid_wide(P + C_MERGED, LDP, (const bf16_t*)(ws + OFF_WOUT), DM, p.out, p.out, 1.0f, smem); break;
    case 11: phase_norm(p.out, p.in[I_F2N] + l * DM, U); break;
    case 12: phase_ffn_up_wide(U, (const bf16_t*)(ws + OFF_WGU2), P, smem); break;
    case 13: phase_gemm_resid_wide(P, DFF, (const bf16_t*)(ws + OFF_WD2), DFF, p.out, p.out, 0.5f, smem); break;
  }
}

__global__ void __launch_bounds__(NTHREADS, 2) fwd_megakernel(Params p, int ph0, int ph1) {
  __shared__ __attribute__((aligned(16))) unsigned char smem[SMEM_BYTES];
  __shared__ uint4 xb_words;
  cg::grid_group grid = cg::this_grid();
  if (TIDX == 0) xb_words = make_uint4(0u, 0u, 0u, 0u);
  __syncthreads();
  XcdBarrier xb = xcd_barrier_post((unsigned*)(p.ws + OFF_BAR), (volatile LDS_AS unsigned*)&xb_words);
  for (int ph = ph0; ph <= ph1; ++ph) {
    run_phase(p, ph, smem);
#ifdef DBL_PHASE
    if (ph == DBL_PHASE) { xcd_barrier(xb); run_phase(p, ph, smem); }
#endif
#ifdef XSYNC
    xcd_barrier(xb);
#endif
    if (ph < ph1) {
      if (ph == ph0) grid.sync();
      else xcd_barrier(xb);
    }
  }
}

extern "C" void kernel_launch(void* const* d_in, const int* in_sizes, int n_in, void* d_out, int out_size, void* d_ws, size_t ws_size,
                              hipStream_t stream) {
  static int grid_blocks = 0;
  if (!grid_blocks) {
    int dev = 0, cus = 0, per_cu = 0;
    hipGetDevice(&dev);
    hipDeviceGetAttribute(&cus, hipDeviceAttributeMultiprocessorCount, dev);
    hipOccupancyMaxActiveBlocksPerMultiprocessor(&per_cu, fwd_megakernel, NTHREADS, 0);
    if (per_cu > 2) per_cu = 2;
    grid_blocks = cus * per_cu;
  }
  if (ws_size < WS_NEED || n_in < 27 || grid_blocks <= 0) { fprintf(stderr, "bad setup ws=%zu need=%zu grid=%d\n", ws_size, (size_t)WS_NEED, grid_blocks); return; }
  Params p{};
  for (int i = 0; i < 27; ++i) p.in[i] = (const float*)d_in[i];
  p.out = (float*)d_out;
  p.ws = (unsigned char*)d_ws;
  for (int i = 0; i < 32; ++i) p.inv_freq[i] = pow(10000.0, -(double)i / 32.0);
  int ph0 = 0, ph1 = 2 * PH_PER_LAYER - 1;
  void* args[] = {&p, &ph0, &ph1};
  hipMemsetAsync((unsigned char*)d_ws + OFF_BAR, 0, 16384, stream);
  hipError_t e = hipLaunchCooperativeKernel((void*)fwd_megakernel, dim3(grid_blocks), dim3(NTHREADS), args, 0, stream);
  if (e != hipSuccess) fprintf(stderr, "cooperative launch failed: %s (grid %d)\n", hipGetErrorString(e), grid_blocks);
}
```

```cpp
#include <hip/hip_runtime.h>
#include <hip/hip_cooperative_groups.h>
#include <stdint.h>
#include <math.h>
#include <cstdio>
namespace cg = cooperative_groups;

typedef unsigned short bf16_t;
typedef short bf16x8 __attribute__((ext_vector_type(8)));
typedef short bf16x4 __attribute__((ext_vector_type(4)));
typedef float f32x4 __attribute__((ext_vector_type(4)));
typedef float f32x16 __attribute__((ext_vector_type(16)));
typedef unsigned u32x4 __attribute__((ext_vector_type(4)));
typedef unsigned u32x2 __attribute__((ext_vector_type(2)));

#define NTHREADS 256
#ifndef LEANV
#define LEANV 0
#endif
#ifndef DBG_MASK
#define DBG_MASK 0
#endif
__device__ __forceinline__ int launder_tid() { int t = threadIdx.x; asm volatile("" : "+v"(t)); return t; }
#define TIDX launder_tid()
__device__ __forceinline__ int wave_id() { return __builtin_amdgcn_readfirstlane(launder_tid() >> 6); }
#define WAVE wave_id()
#define SMEM_BYTES 69632

constexpr int T_SEQ = 8192;
constexpr int MTOK = 32768;
constexpr int DM = 1024;
constexpr int DFF = 2816;
constexpr int LDP = 5248;
constexpr int INTOT = 9240;
constexpr int C_AQ = 0, C_AK = 512, C_AV = 640, C_BX = 768, C_BB = 1280, C_BC = 1792, C_CQ = 2304, C_CKC = 2816,
              C_CVC = 2944, C_CKS = 3072, C_CVS = 3200, C_CKW = 3328, C_CVW = 3456, C_CG = 3584, C_DQ = 3712,
              C_DK = 3968, C_DV = 4224, C_DG = 4736, C_MERGED = 2816;

constexpr size_t OFF_WGU1 = 0;
constexpr size_t OFF_WD1 = OFF_WGU1 + (size_t)5632 * 1024 * 2;
constexpr size_t OFF_WIN = OFF_WD1 + (size_t)1024 * 2816 * 2;
constexpr size_t OFF_WGATE = OFF_WIN + (size_t)LDP * 1024 * 2;
constexpr size_t OFF_WBR = OFF_WGATE + (size_t)4096 * 1024 * 2;
constexpr size_t OFF_WOUT = OFF_WBR + (size_t)4 * 1024 * 512 * 2;
constexpr size_t OFF_WGU2 = OFF_WOUT + (size_t)1024 * 1024 * 2;
constexpr size_t OFF_WD2 = OFF_WGU2 + (size_t)5632 * 1024 * 2;
constexpr size_t OFF_WCK1 = OFF_WD2 + (size_t)1024 * 2816 * 2;
constexpr size_t OFF_WCV1 = OFF_WCK1 + (size_t)256 * 2048 * 2;
constexpr size_t OFF_U = OFF_WCV1 + (size_t)256 * 2048 * 2;
constexpr size_t OFF_P = OFF_U + (size_t)MTOK * 1024 * 2;
constexpr size_t OFF_RT = OFF_P + (size_t)(MTOK + 64) * LDP * 2;
constexpr size_t OFF_CMPH = OFF_RT + (size_t)16 * 64 * 8192 * 2;
constexpr size_t OFF_KCMP = OFF_CMPH + (size_t)2 * 4096 * 256 * 2;
constexpr size_t OFF_VCMP = OFF_KCMP + (size_t)8 * 512 * 64 * 2;
constexpr size_t OFF_ROPE = OFF_VCMP + (size_t)8 * 512 * 64 * 2;
constexpr size_t OFF_CB1 = OFF_ROPE + (size_t)8192 * 32 * 8;
constexpr size_t OFF_BAR = OFF_CB1 + 4096;
constexpr size_t WS_NEED = OFF_BAR + 16384;

struct Params {
  const float* in[27];
  float* out;
  unsigned char* ws;
  double inv_freq[32];
};

enum { I_X = 0, I_F1N, I_F1G, I_F1U, I_F1D, I_MIXN, I_WIN, I_MGB, I_SWAQG, I_SWAKG, I_SINK, I_CONVW, I_NSAQG, I_NSAKG,
       I_POSK, I_POSV, I_WK1, I_WK2, I_WV1, I_WV2, I_RETG, I_WBR, I_WOUT, I_F2N, I_F2G, I_F2U, I_F2D };

__device__ __forceinline__ unsigned short f2bf(float f) {
  unsigned u = __float_as_uint(f);
  u += 0x7fffu + ((u >> 16) & 1u);
  return (unsigned short)(u >> 16);
}
__device__ __forceinline__ float bf2f(unsigned short h) { return __uint_as_float(((unsigned)h) << 16); }
__device__ __forceinline__ unsigned pack2(float lo, float hi) { return (unsigned)f2bf(lo) | ((unsigned)f2bf(hi) << 16); }
__device__ __forceinline__ float sigmoidf_(float x) { return 1.f / (1.f + __expf(-x)); }
__device__ __forceinline__ float siluf_(float x) { return x / (1.f + __expf(-x)); }
__device__ __forceinline__ float gelu_tanh(float x) {
  float u = 0.7978845608028654f * (x + 0.044715f * x * x * x);
  float t = 1.f - 2.f / (1.f + __expf(2.f * u));
  return 0.5f * x * (1.f + t);
}
__device__ __forceinline__ int swz(int row, int chunk) { return row * 128 + (((chunk) ^ ((row >> 1) & 7)) << 4); }

__device__ __forceinline__ void convert_job(const float* src0, const float* src1, int Nsrc, int K, bf16_t* dst, int Ndst, int kind, int coloff, unsigned char* smem, bool pack32 = false, int pack_rows = 1 << 30) {
  const int t = TIDX;
  const int nkb = K >> 6, nrb = Ndst >> 6;
  const int nunits = nkb * nrb;
  bf16_t* tl = (bf16_t*)smem;
  const int n4 = (t & 15) * 4, kr = t >> 4;
  for (int u = blockIdx.x; u < nunits; u += gridDim.x) {
    const int rb = u / nkb, kb = u % nkb;
    __syncthreads();
    const int r = rb * 64 + n4;
    const float* sp = src0; int col;
    if (kind == 0) col = r + coloff;
    else if (kind == 1) { const int sel = (r >> 4) & 1; col = 16 * (r >> 5) + (r & 15); sp = sel ? src1 : src0; }
    else { col = (r < 3608) ? r : ((r < 3712) ? -1 : r - 104); }
    f32x4 v[4];
#pragma unroll
    for (int ps = 0; ps < 4; ++ps) {
      v[ps] = (f32x4){0.f, 0.f, 0.f, 0.f};
      if (col >= 0) v[ps] = *(const f32x4*)(sp + (size_t)(kb * 64 + ps * 16 + kr) * Nsrc + col);
    }
#pragma unroll
    for (int ps = 0; ps < 4; ++ps)
#pragma unroll
      for (int e = 0; e < 4; ++e) tl[(n4 + e) * 66 + ps * 16 + kr] = f2bf(v[ps][e]);
    __syncthreads();
#pragma unroll
    for (int i = 0; i < 2; ++i) {
      const int n = (t >> 3) + 32 * i, c = t & 7;
      const unsigned* lp = (const unsigned*)(tl + n * 66 + c * 8);
      u32x4 o; o.x = lp[0]; o.y = lp[1]; o.z = lp[2]; o.w = lp[3];
      if (!pack32 || rb * 64 + n >= pack_rows) *(u32x4*)(dst + (size_t)(rb * 64 + n) * K + kb * 64 + c * 8) = o;
      else {
        const int nn = rb * 64 + n, rowi = nn & 15, ch = c & 3, phys = ch ^ ((0x1320 >> (((rowi >> 2) & 3) * 4)) & 3);
        *(u32x4*)(dst + ((size_t)(nn >> 4) * (K >> 5) + kb * 2 + (c >> 2)) * 512 + rowi * 32 + phys * 8) = o;
      }
    }
  }
}

__device__ __forceinline__ void phase_convert(const Params& p, int l, unsigned char* smem) {
  unsigned char* ws = p.ws;
  convert_job(p.in[I_F1G] + (size_t)l * DM * DFF, p.in[I_F1U] + (size_t)l * DM * DFF, DFF, DM, (bf16_t*)(ws + OFF_WGU1), 5632, 1, 0, smem, true);
  convert_job(p.in[I_F1D] + (size_t)l * DFF * DM, nullptr, DM, DFF, (bf16_t*)(ws + OFF_WD1), 1024, 0, 0, smem, true);
  convert_job(p.in[I_WIN] + (size_t)l * DM * INTOT, nullptr, INTOT, DM, (bf16_t*)(ws + OFF_WIN), LDP, 2, 0, smem, true, 5120);
  convert_job(p.in[I_WIN] + (size_t)l * DM * INTOT, nullptr, INTOT, DM, (bf16_t*)(ws + OFF_WGATE), 4096, 0, 5144, smem);
  for (int i = 0; i < 4; ++i)
    convert_job(p.in[I_WBR] + ((size_t)l * 4 + i) * 512 * DM, nullptr, DM, 512, (bf16_t*)(ws + OFF_WBR) + (size_t)i * 1024 * 512, 1024, 0, 0, smem);
  convert_job(p.in[I_WOUT] + (size_t)l * DM * DM, nullptr, DM, DM, (bf16_t*)(ws + OFF_WOUT), 1024, 0, 0, smem, true);
  convert_job(p.in[I_F2G] + (size_t)l * DM * DFF, p.in[I_F2U] + (size_t)l * DM * DFF, DFF, DM, (bf16_t*)(ws + OFF_WGU2), 5632, 1, 0, smem, true);
  convert_job(p.in[I_F2D] + (size_t)l * DFF * DM, nullptr, DM, DFF, (bf16_t*)(ws + OFF_WD2), 1024, 0, 0, smem, true);
  convert_job(p.in[I_WK1] + (size_t)l * 2048 * 256, nullptr, 256, 2048, (bf16_t*)(ws + OFF_WCK1), 256, 0, 0, smem);
  convert_job(p.in[I_WV1] + (size_t)l * 2048 * 256, nullptr, 256, 2048, (bf16_t*)(ws + OFF_WCV1), 256, 0, 0, smem);
  if (blockIdx.x < 8) {
    __syncthreads();
    const int kv = blockIdx.x >> 2, jc = blockIdx.x & 3, t = TIDX, j = jc * 64 + (t & 63), kq = t >> 6;
    const float* pe = p.in[kv ? I_POSV : I_POSK] + (size_t)l * 2048 + kq * 512;
    const float* w1 = p.in[kv ? I_WV1 : I_WK1] + (size_t)l * 2048 * 256 + (size_t)kq * 512 * 256 + j;
    float sacc = 0.f;
    for (int k0 = 0; k0 < 512; k0 += 16) {
      float wv[16], pv[16];
#pragma unroll
      for (int u = 0; u < 16; ++u) { wv[u] = w1[(size_t)(k0 + u) * 256]; pv[u] = pe[k0 + u]; }
#pragma unroll
      for (int u = 0; u < 16; ++u) sacc += pv[u] * wv[u];
    }
    float* red = (float*)smem;
    red[kq * 64 + (t & 63)] = sacc;
    __syncthreads();
    if (t < 64) ((float*)(ws + OFF_CB1))[kv * 256 + jc * 64 + t] = ((red[t] + red[64 + t]) + red[128 + t]) + red[192 + t];
  }
  if (l == 0) {
    float2* tab = (float2*)(ws + OFF_ROPE);
    for (int i = blockIdx.x * NTHREADS + TIDX; i < 8192 * 32; i += gridDim.x * NTHREADS) {
      const int pos = i >> 5, f = i & 31;
      double rev = (double)pos * p.inv_freq[f] * 0.15915494309189535;
      rev = rev - floor(rev);
      float fr = (float)rev;
      tab[i] = make_float2(__builtin_amdgcn_cosf(fr), __builtin_amdgcn_sinf(fr));
    }
  }
}

__device__ __forceinline__ void phase_norm(const float* x, const float* gain, bf16_t* dst) {
  const int lane = TIDX & 63;
  const int gw = blockIdx.x * 4 + WAVE, nw = gridDim.x * 4;
  f32x4 g[4];
#pragma unroll
  for (int i = 0; i < 4; ++i) g[i] = *(const f32x4*)(gain + i * 256 + lane * 4);
  for (int row = gw; row < MTOK; row += 2 * nw) {
    const int row2 = row + nw;
    const bool has2 = row2 < MTOK;
    const float* xr = x + (size_t)row * DM; const float* xr2 = x + (size_t)(has2 ? row2 : row) * DM;
    f32x4 v[4], v2[4]; float ss = 0.f, ss2 = 0.f;
#pragma unroll
    for (int i = 0; i < 4; ++i) { v[i] = *(const f32x4*)(xr + i * 256 + lane * 4); v2[i] = *(const f32x4*)(xr2 + i * 256 + lane * 4); }
#pragma unroll
    for (int i = 0; i < 4; ++i) {
      ss += v[i][0] * v[i][0] + v[i][1] * v[i][1] + v[i][2] * v[i][2] + v[i][3] * v[i][3];
      ss2 += v2[i][0] * v2[i][0] + v2[i][1] * v2[i][1] + v2[i][2] * v2[i][2] + v2[i][3] * v2[i][3];
    }
#pragma unroll
    for (int o = 32; o >= 1; o >>= 1) { ss += __shfl_xor(ss, o); ss2 += __shfl_xor(ss2, o); }
    const float rs = rsqrtf(ss * (1.f / 1024.f) + 1e-6f), rs2 = rsqrtf(ss2 * (1.f / 1024.f) + 1e-6f);
#pragma unroll
    for (int i = 0; i < 4; ++i) {
      u32x2 o; o.x = pack2(v[i][0] * rs * g[i][0], v[i][1] * rs * g[i][1]); o.y = pack2(v[i][2] * rs * g[i][2], v[i][3] * rs * g[i][3]);
      *(u32x2*)(dst + (size_t)row * DM + i * 256 + lane * 4) = o;
      if (has2) {
        u32x2 o2; o2.x = pack2(v2[i][0] * rs2 * g[i][0], v2[i][1] * rs2 * g[i][1]); o2.y = pack2(v2[i][2] * rs2 * g[i][2], v2[i][3] * rs2 * g[i][3]);
        *(u32x2*)(dst + (size_t)row2 * DM + i * 256 + lane * 4) = o2;
      }
    }
  }
}

#define LDS_AS __attribute__((address_space(3)))
template <int AMODE, int NI>
__device__ __forceinline__ void gemm_mainloop(f32x4 (&acc)[4][NI], const bf16_t* __restrict__ A, long lda, long lda2,
                                              const bf16_t* __restrict__ B, long ldb, int K, int m0, int n0, unsigned char* smem,
                                              bool pre = false, int nm0 = -1, int nn0 = 0) {
  const int lane = TIDX & 63, w = WAVE, wr = w >> 1, wc = w & 1, fr = lane & 15, fq = lane >> 4;
  const int lr = lane >> 3, ph = lane & 7;
  const bf16_t* ap[4]; const bf16_t* bp[NI];
#pragma unroll
  for (int j = 0; j < 4; ++j) {
    const int row = w * 32 + j * 8 + lr, R = m0 + row, c = ph ^ ((row >> 1) & 7);
    if (AMODE == 0) ap[j] = A + (size_t)R * lda + c * 8;
    else { const int bg = R >> 9, n = R & 511; ap[j] = A + ((size_t)(bg >> 1) * T_SEQ + n * 16) * lda + (bg & 1) * 64 + c * 8; }
  }
#pragma unroll
  for (int j = 0; j < NI; ++j) {
    const int row = w * 8 * NI + j * 8 + lr, c = ph ^ ((row >> 1) & 7);
    bp[j] = B + (size_t)(n0 + row) * ldb + c * 8;
  }
  unsigned char* As = smem; unsigned char* Bs = smem + 32768;
  const int a_l = (w * 32) * 128 + lane * 16, b_l = (w * 8 * NI) * 128 + lane * 16;
  const int nk = K >> 6;
  auto issue = [&](int kt, int buf) {
#pragma unroll
    for (int j = 0; j < 4; ++j)
      __builtin_amdgcn_global_load_lds((const unsigned*)(ap[j] + (size_t)kt * lda2), (LDS_AS unsigned*)(As + buf * 16384 + a_l + j * 1024), 16, 0, 0);
#pragma unroll
    for (int j = 0; j < NI; ++j)
      __builtin_amdgcn_global_load_lds((const unsigned*)(bp[j] + (size_t)kt * 64), (LDS_AS unsigned*)(Bs + buf * 16384 + b_l + j * 1024), 16, 0, 0);
  };
  if (!pre) {
    __syncthreads();
    issue(0, 0);
  }
  for (int kt = 0; kt < nk; ++kt) {
    const int cur = kt & 1;
    __syncthreads();
    const unsigned char* a_s = As + cur * 16384; const unsigned char* b_s = Bs + cur * 16384;
    bf16x8 xf[2][4], wf[2][NI];
#pragma unroll
    for (int ks = 0; ks < 2; ++ks) {
#pragma unroll
      for (int i = 0; i < 4; ++i) xf[ks][i] = *(const bf16x8*)(a_s + swz(wr * 64 + 16 * i + fr, ks * 4 + fq));
#pragma unroll
      for (int i = 0; i < NI; ++i) wf[ks][i] = *(const bf16x8*)(b_s + swz(wc * 16 * NI + 16 * i + fr, ks * 4 + fq));
    }
    if (kt + 1 < nk) issue(kt + 1, cur ^ 1);
    else if (nm0 >= 0) {
      const long da = (long)(nm0 - m0) * lda, db = (long)(nn0 - n0) * ldb;
#pragma unroll
      for (int j = 0; j < 4; ++j)
        __builtin_amdgcn_global_load_lds((const unsigned*)(ap[j] + da), (LDS_AS unsigned*)(As + a_l + j * 1024), 16, 0, 0);
#pragma unroll
      for (int j = 0; j < NI; ++j)
        __builtin_amdgcn_global_load_lds((const unsigned*)(bp[j] + db), (LDS_AS unsigned*)(Bs + b_l + j * 1024), 16, 0, 0);
    }
#pragma unroll
    for (int ks = 0; ks < 2; ++ks)
#pragma unroll
      for (int mi = 0; mi < 4; ++mi)
#pragma unroll
        for (int ni = 0; ni < NI; ++ni) acc[mi][ni] = __builtin_amdgcn_mfma_f32_16x16x32_bf16(wf[ks][ni], xf[ks][mi], acc[mi][ni], 0, 0, 0);
  }
}

template <int NI>
__device__ __forceinline__ void zero_acc(f32x4 (&acc)[4][NI]) {
#pragma unroll
  for (int i = 0; i < 4; ++i)
#pragma unroll
    for (int j = 0; j < NI; ++j) acc[i][j] = (f32x4){0.f, 0.f, 0.f, 0.f};
}
__device__ __forceinline__ int xcd_tile(int r, int nN, int& mt, int& nt) {
  const int G8 = gridDim.x >> 3, x = blockIdx.x & 7, slot = blockIdx.x >> 3;
  const int per = 8 * nN, total = 4 * per, nfull = nN >> 2;
  const int L = r * G8 + slot;
  if (L >= total) return -1;
  const int sbm = L / per, Lin = L - sbm * per;
  int sbn, within;
  if (Lin < 32 * nfull) { sbn = Lin >> 5; within = Lin & 31; }
  else { sbn = nfull; within = Lin - 32 * nfull; }
  mt = 32 * x + 8 * sbm + (within & 7); nt = 4 * sbn + (within >> 3);
  return 1;
}
__device__ __forceinline__ void tile_of(int id, int nN, int& mt, int& nt) {
  const int per = 8 * nN; const int g = id / per, rem = id % per;
  mt = g * 8 + (rem & 7); nt = rem >> 3;
}

__device__ __forceinline__ bool next_valid(int& rr, int nN, int& mt, int& nt) {
  for (;;) { const int st = xcd_tile(rr, nN, mt, nt); ++rr; if (st < 0) return false; if (st > 0) return true; }
}
__device__ __forceinline__ void phase_ffn_up(const bf16_t* U, const bf16_t* Wgu, bf16_t* H, unsigned char* smem) {
  const int lane = TIDX & 63, w = WAVE, wr = w >> 1, wc = w & 1, fr = lane & 15, fq = lane >> 4;
  const int nN = 5632 / 128, ntiles = (MTOK / 128) * nN;
  int rr = 0, mt, nt, mt2 = 0, nt2 = 0;
  bool have = next_valid(rr, nN, mt, nt), pre = false;
  for (; have; mt = mt2, nt = nt2) {
    const bool have2 = next_valid(rr, nN, mt2, nt2);
    f32x4 acc[4][4]; zero_acc(acc);
    gemm_mainloop<0, 4>(acc, U, DM, 64, Wgu, DM, DM, mt * 128, nt * 128, smem, pre, have2 ? mt2 * 128 : -1, nt2 * 128);
    pre = have2; have = have2;
    const int hb = (nt * 128 + wc * 64) >> 1;
#pragma unroll
    for (int mi = 0; mi < 4; ++mi) {
      const int m = mt * 128 + wr * 64 + 16 * mi + fr;
#pragma unroll
      for (int np = 0; np < 2; ++np) {
        const f32x4 g = acc[mi][2 * np], u = acc[mi][2 * np + 1];
        u32x2 o; o.x = pack2(siluf_(g[0]) * u[0], siluf_(g[1]) * u[1]); o.y = pack2(siluf_(g[2]) * u[2], siluf_(g[3]) * u[3]);
        *(u32x2*)(H + (size_t)m * DFF + hb + 16 * np + 4 * fq) = o;
      }
    }
  }
}


__device__ __forceinline__ int swz32(int row, int chunk) { return row * 64 + ((chunk ^ ((0x1320 >> (((row >> 2) & 3) * 4)) & 3)) << 4); }
__device__ __forceinline__ void gemm_wide(f32x4 (&acc)[4][8], const bf16_t* __restrict__ A, long lda, const bf16_t* __restrict__ Bp,
                                          int K, int m0, int n0, unsigned char* smem, bool pre, int nm0, int nn0) {
  const int lane = TIDX & 63, w = WAVE, wr = w >> 1, wc = w & 1, fr = lane & 15, fq = lane >> 4;
  const int lr = lane >> 2, ph = lane & 3;
  const int kb32 = K >> 5;
  const bf16_t* ap[2]; const bf16_t* bp[4];
#pragma unroll
  for (int j = 0; j < 2; ++j) {
    const int row = w * 32 + j * 16 + lr, c = ph ^ ((0x1320 >> (((row >> 2) & 3) * 4)) & 3);
    ap[j] = A + (size_t)(m0 + row) * lda + c * 8;
  }
#pragma unroll
  for (int j = 0; j < 4; ++j) bp[j] = Bp + (size_t)((n0 + w * 64 + j * 16) >> 4) * kb32 * 512 + lane * 8;
  unsigned char* As = smem; unsigned char* Bs = smem + 16384;
  const int a_l = (w * 32) * 64 + lane * 16, b_l = (w * 64) * 64 + lane * 16;
  const int nk = kb32;
  auto issue = [&](int kt, int buf, long da, long db) {
#pragma unroll
    for (int j = 0; j < 2; ++j)
      __builtin_amdgcn_global_load_lds((const unsigned*)(ap[j] + da + (size_t)kt * 32), (LDS_AS unsigned*)(As + buf * 8192 + a_l + j * 1024), 16, 0, 0);
#pragma unroll
    for (int j = 0; j < 4; ++j)
      __builtin_amdgcn_global_load_lds((const unsigned*)(bp[j] + db + (size_t)kt * 512), (LDS_AS unsigned*)(Bs + buf * 16384 + b_l + j * 1024), 16, 0, 0);
  };
  if (!pre) {
    __syncthreads();
    issue(0, 0, 0, 0);
  }
  for (int kt = 0; kt < nk; ++kt) {
    const int cur = kt & 1;
    __syncthreads();
    const unsigned char* a_s = As + cur * 8192; const unsigned char* b_s = Bs + cur * 16384;
    bf16x8 xf[4], wf[8];
#pragma unroll
    for (int i = 0; i < 4; ++i) xf[i] = *(const bf16x8*)(a_s + swz32(wr * 64 + 16 * i + fr, fq));
#pragma unroll
    for (int i = 0; i < 8; ++i) wf[i] = *(const bf16x8*)(b_s + swz32(wc * 128 + 16 * i + fr, fq));
    if (kt + 1 < nk) issue(kt + 1, cur ^ 1, 0, 0);
    else if (nm0 >= 0) issue(0, 0, (long)(nm0 - m0) * lda, (long)((nn0 - n0) >> 4) * kb32 * 512);
#pragma unroll
    for (int mi = 0; mi < 4; ++mi)
#pragma unroll
      for (int ni = 0; ni < 8; ++ni) acc[mi][ni] = __builtin_amdgcn_mfma_f32_16x16x32_bf16(wf[ni], xf[mi], acc[mi][ni], 0, 0, 0);
  }
}

__device__ __forceinline__ void phase_ffn_up_wide(const bf16_t* U, const bf16_t* Wgu, bf16_t* H, unsigned char* smem) {
  const int lane = TIDX & 63, w = WAVE, wr = w >> 1, wc = w & 1, fr = lane & 15, fq = lane >> 4;
  const int nN = 5632 / 256;
  int rr = 0, mt, nt, mt2 = 0, nt2 = 0;
  bool have = next_valid(rr, nN, mt, nt), pre = false;
  for (; have; mt = mt2, nt = nt2) {
    const bool have2 = next_valid(rr, nN, mt2, nt2);
    f32x4 acc[4][8];
#pragma unroll
    for (int i = 0; i < 4; ++i)
#pragma unroll
      for (int j = 0; j < 8; ++j) acc[i][j] = (f32x4){0.f, 0.f, 0.f, 0.f};
    gemm_wide(acc, U, DM, Wgu, DM, mt * 128, nt * 256, smem, pre, have2 ? mt2 * 128 : -1, nt2 * 256);
    pre = have2; have = have2;
    const int hb = (nt * 256 + wc * 128) >> 1;
#pragma unroll
    for (int mi = 0; mi < 4; ++mi) {
      const int m = mt * 128 + wr * 64 + 16 * mi + fr;
#pragma unroll
      for (int np = 0; np < 4; ++np) {
        const f32x4 g = acc[mi][2 * np], u = acc[mi][2 * np + 1];
        u32x2 o; o.x = pack2(siluf_(g[0]) * u[0], siluf_(g[1]) * u[1]); o.y = pack2(siluf_(g[2]) * u[2], siluf_(g[3]) * u[3]);
        *(u32x2*)(H + (size_t)m * DFF + hb + 16 * np + 4 * fq) = o;
      }
    }
  }
}

__device__ __forceinline__ void phase_gemm_resid(const bf16_t* A, long lda, const bf16_t* Bt, int K, const float* xsrc, float* out, float scale, unsigned char* smem) {
  const int lane = TIDX & 63, w = WAVE, wr = w >> 1, wc = w & 1, fr = lane & 15, fq = lane >> 4;
  const int nN = DM / 128, ntiles = (MTOK / 128) * nN;
  int rr = 0, mt, nt, mt2 = 0, nt2 = 0;
  bool have = next_valid(rr, nN, mt, nt), pre = false;
  for (; have; mt = mt2, nt = nt2) {
    const bool have2 = next_valid(rr, nN, mt2, nt2);
    f32x4 acc[4][4]; zero_acc(acc);
    gemm_mainloop<0, 4>(acc, A, lda, 64, Bt, K, K, mt * 128, nt * 128, smem, pre, have2 ? mt2 * 128 : -1, nt2 * 128);
    pre = have2; have = have2;
#pragma unroll
    for (int mi = 0; mi < 4; ++mi) {
      const int m = mt * 128 + wr * 64 + 16 * mi + fr;
#pragma unroll
      for (int ni = 0; ni < 4; ++ni) {
        const size_t o = (size_t)m * DM + nt * 128 + wc * 64 + 16 * ni + 4 * fq;
        f32x4 xv = *(const f32x4*)(xsrc + o);
        xv = xv + acc[mi][ni] * scale;
        *(f32x4*)(out + o) = xv;
      }
    }
  }
}


__device__ __forceinline__ void phase_gemm_resid_wide(const bf16_t* A, long lda, const bf16_t* Bp, int K, const float* xsrc, float* out, float scale, unsigned char* smem) {
  const int lane = TIDX & 63, w = WAVE, wr = w >> 1, wc = w & 1, fr = lane & 15, fq = lane >> 4;
  const int nN = DM / 256;
  int rr = 0, mt, nt, mt2 = 0, nt2 = 0;
  bool have = next_valid(rr, nN, mt, nt), pre = false;
  for (; have; mt = mt2, nt = nt2) {
    const bool have2 = next_valid(rr, nN, mt2, nt2);
    f32x4 acc[4][8];
#pragma unroll
    for (int i = 0; i < 4; ++i)
#pragma unroll
      for (int j = 0; j < 8; ++j) acc[i][j] = (f32x4){0.f, 0.f, 0.f, 0.f};
    gemm_wide(acc, A, lda, Bp, K, mt * 128, nt * 256, smem, pre, have2 ? mt2 * 128 : -1, nt2 * 256);
    pre = have2; have = have2;
#pragma unroll
    for (int mi = 0; mi < 4; ++mi) {
      const int m = mt * 128 + wr * 64 + 16 * mi + fr;
#pragma unroll
      for (int ni = 0; ni < 8; ++ni) {
        const size_t o = (size_t)m * DM + nt * 256 + wc * 128 + 16 * ni + 4 * fq;
        f32x4 xv = *(const f32x4*)(xsrc + o);
        xv = xv + acc[mi][ni] * scale;
        *(f32x4*)(out + o) = xv;
      }
    }
  }
}

template <int NIT, int OFF>
__device__ __forceinline__ void proj_epi(const Params& p, int l, f32x4 (&acc)[4][NIT], int mrow0, int nb, int fr, int fq) {
  bf16_t* P = (bf16_t*)(p.ws + OFF_P);
  const float2* rope = (const float2*)(p.ws + OFF_ROPE);
  const int cidx = nb >> 6;
  int type = 0; const float* gain = nullptr; float scale = 1.f;
  if (cidx < 8) { type = 1; gain = p.in[I_SWAQG] + l * 64; scale = 0.125f * 1.4426950408889634f; }
  else if (cidx < 10) { type = 1; gain = p.in[I_SWAKG] + l * 64; }
  else if (cidx >= 36 && cidx < 44) { type = 1; gain = p.in[I_NSAQG] + l * 64; scale = 0.125f * 1.4426950408889634f; }
  else if (cidx == 48 || cidx == 49) { type = 1; gain = p.in[I_NSAKG] + l * 192 + 64; }
  else if (cidx == 52 || cidx == 53) { type = 1; gain = p.in[I_NSAKG] + l * 192 + 128; }
  else if (cidx >= 58 && cidx < 62) { type = 2; }
  else if (cidx >= 62 && cidx < 66) { type = 2; scale = 0.125f; }
  if (type == 1) {
    f32x4 gv[4];
#pragma unroll
    for (int ni = 0; ni < 4; ++ni) gv[ni] = *(const f32x4*)(gain + 16 * ni + 4 * fq) * scale;
#pragma unroll
    for (int mi = 0; mi < 4; ++mi) {
      float ss = 0.f;
#pragma unroll
      for (int ni = 0; ni < 4; ++ni) { const f32x4 a = acc[mi][OFF + ni]; ss += a[0] * a[0] + a[1] * a[1] + a[2] * a[2] + a[3] * a[3]; }
      ss += __shfl_xor(ss, 16); ss += __shfl_xor(ss, 32);
      const float rs = rsqrtf(ss * (1.f / 64.f) + 1e-6f);
#pragma unroll
      for (int ni = 0; ni < 4; ++ni) acc[mi][OFF + ni] = acc[mi][OFF + ni] * rs * gv[ni];
    }
  } else if (type == 2) {
#pragma unroll
    for (int mi = 0; mi < 4; ++mi) {
      const int m = mrow0 + 16 * mi + fr, pos = m & (T_SEQ - 1);
#pragma unroll
      for (int ni = 0; ni < 2; ++ni) {
        const float2* tp = rope + pos * 32 + 16 * ni + 4 * fq;
#pragma unroll
        for (int r = 0; r < 4; ++r) {
          const float2 cs = tp[r];
          const float x1 = acc[mi][OFF + ni][r], x2 = acc[mi][OFF + ni + 2][r];
          acc[mi][OFF + ni][r] = (x1 * cs.x - x2 * cs.y) * scale;
          acc[mi][OFF + ni + 2][r] = (x1 * cs.y + x2 * cs.x) * scale;
        }
      }
    }
  }
#pragma unroll
  for (int mi = 0; mi < 4; ++mi) {
    const int m = mrow0 + 16 * mi + fr;
#pragma unroll
    for (int ni = 0; ni < 4; ++ni) {
      u32x2 o; o.x = pack2(acc[mi][OFF + ni][0], acc[mi][OFF + ni][1]); o.y = pack2(acc[mi][OFF + ni][2], acc[mi][OFF + ni][3]);
      *(u32x2*)(P + (size_t)m * LDP + nb + 16 * ni + 4 * fq) = o;
    }
  }
}

__device__ __forceinline__ void phase_proj(const Params& p, int l, unsigned char* smem) {
  const int lane = TIDX & 63, w = WAVE, wr = w >> 1, wc = w & 1, fr = lane & 15, fq = lane >> 4;
  const bf16_t* U = (const bf16_t*)(p.ws + OFF_U);
  const bf16_t* W = (const bf16_t*)(p.ws + OFF_WIN);
  {
    const int nN = 20;
    int rr = 0, mt, nt, mt2 = 0, nt2 = 0;
    bool have = next_valid(rr, nN, mt, nt), pre = false;
    for (; have; mt = mt2, nt = nt2) {
      const bool have2 = next_valid(rr, nN, mt2, nt2);
      f32x4 acc[4][8];
#pragma unroll
      for (int i = 0; i < 4; ++i)
#pragma unroll
        for (int j = 0; j < 8; ++j) acc[i][j] = (f32x4){0.f, 0.f, 0.f, 0.f};
      gemm_wide(acc, U, DM, W, DM, mt * 128, nt * 256, smem, pre, have2 ? mt2 * 128 : -1, nt2 * 256);
      pre = have2; have = have2;
      proj_epi<8, 0>(p, l, acc, mt * 128 + wr * 64, nt * 256 + wc * 128, fr, fq);
      proj_epi<8, 4>(p, l, acc, mt * 128 + wr * 64, nt * 256 + wc * 128 + 64, fr, fq);
    }
  }
  {
    const int nN = 1;
    int rr = 0, mt, nt, mt2 = 0, nt2 = 0;
    bool have = next_valid(rr, nN, mt, nt), pre = false;
    for (; have; mt = mt2, nt = nt2) {
      const bool have2 = next_valid(rr, nN, mt2, nt2);
      f32x4 acc[4][4]; zero_acc(acc);
      gemm_mainloop<0, 4>(acc, U, DM, 64, W + (size_t)5120 * DM, DM, DM, mt * 128, 0, smem, pre, have2 ? mt2 * 128 : -1, 0);
      pre = have2; have = have2;
      proj_epi<4, 0>(p, l, acc, mt * 128 + wr * 64, 5120 + wc * 64, fr, fq);
    }
  }
}

__device__ __forceinline__ void compress_gemm1_tile(const Params& p, int id, unsigned char* smem) {
  const int lane = TIDX & 63, w = WAVE, wr = w >> 1, wc = w & 1, fr = lane & 15, fq = lane >> 4;
  const int kv = id >> 6, rem = id & 63, mt = rem >> 1, nt = rem & 1;
  const bf16_t* P = (const bf16_t*)(p.ws + OFF_P);
  const bf16_t* A = P + (kv ? C_CVC : C_CKC);
  const bf16_t* W = (const bf16_t*)(p.ws + (kv ? OFF_WCV1 : OFF_WCK1));
  const float* bias = (const float*)(p.ws + OFF_CB1) + kv * 256;
  bf16_t* H = (bf16_t*)(p.ws + OFF_CMPH) + (size_t)kv * 4096 * 256;
  f32x4 acc[4][4]; zero_acc(acc);
  gemm_mainloop<1, 4>(acc, A, LDP, LDP, W, 2048, 2048, mt * 128, nt * 128, smem);
#pragma unroll
  for (int mi = 0; mi < 4; ++mi) {
    const int m = mt * 128 + wr * 64 + 16 * mi + fr;
#pragma unroll
    for (int ni = 0; ni < 4; ++ni) {
      const int n = nt * 128 + wc * 64 + 16 * ni + 4 * fq;
      const f32x4 bv = *(const f32x4*)(bias + n);
      const f32x4 a = acc[mi][ni] + bv;
      u32x2 o; o.x = pack2(gelu_tanh(a[0]), gelu_tanh(a[1])); o.y = pack2(gelu_tanh(a[2]), gelu_tanh(a[3]));
      *(u32x2*)(H + (size_t)m * 256 + n) = o;
    }
  }
}

__device__ __forceinline__ void phase_merge(const Params& p, int l, unsigned char* smem) {
  const int lane = TIDX & 63, w = WAVE, wr = w >> 1, wc = w & 1, fr = lane & 15, fq = lane >> 4;
  const bf16_t* U = (const bf16_t*)(p.ws + OFF_U);
  bf16_t* P = (bf16_t*)(p.ws + OFF_P);
  const bf16_t* Wg = (const bf16_t*)(p.ws + OFF_WGATE);
  const bf16_t* Wb = (const bf16_t*)(p.ws + OFF_WBR);
  const float* bias = p.in[I_MGB] + (size_t)l * 4096;
  const int nN = DM / 128;
  for (int rr = 0;; ++rr) {
    int mt, nt; const int st = xcd_tile(rr, nN, mt, nt);
    if (st < 0) break;
    if (st == 0) continue;
    const int nb = nt * 128 + wc * 64;
    unsigned mrg[4][4][2];
#pragma unroll
    for (int mi = 0; mi < 4; ++mi)
#pragma unroll
      for (int ni = 0; ni < 4; ++ni) { mrg[mi][ni][0] = 0u; mrg[mi][ni][1] = 0u; }
    for (int i = 0; i < 4; ++i) {
      const int ycol = (i == 0) ? C_AQ : (i == 1) ? C_BB : (i == 2) ? C_CQ : C_DG;
      unsigned sg[4][4][2];
      {
        f32x4 acc[4][4]; zero_acc<4>(acc);
        gemm_mainloop<0, 4>(acc, U, DM, 64, Wg + (size_t)i * 1024 * 1024, DM, DM, mt * 128, nt * 128, smem);
#pragma unroll
        for (int ni = 0; ni < 4; ++ni) {
          const f32x4 bv = *(const f32x4*)(bias + i * 1024 + nb + 16 * ni + 4 * fq);
#pragma unroll
          for (int mi = 0; mi < 4; ++mi) {
            const f32x4 a = acc[mi][ni] + bv;
            sg[mi][ni][0] = pack2(sigmoidf_(a[0]), sigmoidf_(a[1]));
            sg[mi][ni][1] = pack2(sigmoidf_(a[2]), sigmoidf_(a[3]));
          }
        }
      }
      f32x4 acc[4][4]; zero_acc<4>(acc);
      gemm_mainloop<0, 4>(acc, P + ycol, LDP, 64, Wb + (size_t)i * 1024 * 512, 512, 512, mt * 128, nt * 128, smem);
#pragma unroll
      for (int mi = 0; mi < 4; ++mi)
#pragma unroll
        for (int ni = 0; ni < 4; ++ni) {
          f32x4 sv;
          sv[0] = __uint_as_float(sg[mi][ni][0] << 16); sv[1] = __uint_as_float(sg[mi][ni][0] & 0xffff0000u);
          sv[2] = __uint_as_float(sg[mi][ni][1] << 16); sv[3] = __uint_as_float(sg[mi][ni][1] & 0xffff0000u);
          const f32x4 t4 = sv * acc[mi][ni];
          const unsigned m0 = mrg[mi][ni][0], m1 = mrg[mi][ni][1];
          mrg[mi][ni][0] = pack2(__uint_as_float(m0 << 16) + t4[0], __uint_as_float(m0 & 0xffff0000u) + t4[1]);
          mrg[mi][ni][1] = pack2(__uint_as_float(m1 << 16) + t4[2], __uint_as_float(m1 & 0xffff0000u) + t4[3]);
        }
    }
#pragma unroll
    for (int mi = 0; mi < 4; ++mi) {
      const int m = mt * 128 + wr * 64 + 16 * mi + fr;
#pragma unroll
      for (int ni = 0; ni < 4; ++ni) {
        u32x2 o; o.x = mrg[mi][ni][0]; o.y = mrg[mi][ni][1];
        *(u32x2*)(P + (size_t)m * LDP + C_MERGED + nb + 16 * ni + 4 * fq) = o;
      }
    }
  }
}

#define MFMA32(a, b, c) __builtin_amdgcn_mfma_f32_32x32x16_bf16(a, b, c, 0, 0, 0)
constexpr int AL_K = 0;
constexpr int AL_VT = 8192;
constexpr int KVB = 16896;
constexpr int AL_IMP = 33792;
constexpr int AL_SEL = 66816;
constexpr int AL_UNI = 67840;
constexpr int VTS = 68;

union FragU { u32x4 u; bf16x8 b; };
typedef short v4i16_t __attribute__((ext_vector_type(4)));
__device__ __forceinline__ int vtr_lane_off(int lane) {
  const int g = lane >> 4, q = (lane & 15) >> 2, p = lane & 3, h = lane >> 5;
  return (4 * h + q) * 128 + ((4 * (q >> 1) + 2 * (g & 1) + (p >> 1)) << 4) + 8 * (p & 1);
}
__device__ __forceinline__ bf16x8 vtr_frag(const unsigned char* vimg, int loff, int dt, int mt, int s) {
  const unsigned char* a = vimg + ((loff ^ (dt << 6)) + (32 * mt + 16 * s) * 128);
  const v4i16_t lo = __builtin_amdgcn_ds_read_tr16_b64_v4i16((LDS_AS v4i16_t*)a);
  const v4i16_t hi = __builtin_amdgcn_ds_read_tr16_b64_v4i16((LDS_AS v4i16_t*)(a + 8 * 128));
  return (bf16x8){lo[0], lo[1], lo[2], lo[3], hi[0], hi[1], hi[2], hi[3]};
}
struct KVRegs { u32x4 k[2], v[2]; };

__device__ __forceinline__ void kv_load(KVRegs& R, const bf16_t* kbase, const bf16_t* vbase, long stride, int key0, bool want_v) {
  const int t = TIDX, c = t & 7, r0 = t >> 3;
#pragma unroll
  for (int i = 0; i < 2; ++i) {
    const size_t o = (size_t)(key0 + r0 + 32 * i) * stride + c * 8;
    R.k[i] = *(const u32x4*)(kbase + o);
    if (want_v) R.v[i] = *(const u32x4*)(vbase + o);
  }
}
__device__ __forceinline__ void kv_store(const KVRegs& R, unsigned char* smem, bool want_v) {
  const int t = TIDX, c = t & 7, r0 = t >> 3;
#pragma unroll
  for (int i = 0; i < 2; ++i) {
    const int row = r0 + 32 * i;
    *(u32x4*)(smem + AL_K + swz(row, c)) = R.k[i];
    if (want_v) *(u32x4*)(smem + AL_VT + row * 128 + ((c ^ (((row >> 1) & 1) << 2)) << 4)) = R.v[i];
  }
}
template <bool QL>
__device__ __forceinline__ void compute_S(const bf16x8 (&q)[4], int nt, f32x16 (&S)[2], const unsigned char* smem, int lane) {
  const int r = lane & 31, h = lane >> 5;
  const unsigned char* qp = smem + AL_IMP + WAVE * 8192 + nt * 4096 + lane * 16;
#pragma unroll
  for (int mt = 0; mt < 2; ++mt) {
#pragma unroll
    for (int i = 0; i < 16; ++i) S[mt][i] = 0.f;
#pragma unroll
    for (int ks = 0; ks < 4; ++ks) {
      const bf16x8 kf = *(const bf16x8*)(smem + AL_K + swz(32 * mt + r, 2 * ks + h));
      const bf16x8 qf = QL ? *(const bf16x8*)(qp + ks * 1024) : q[ks];
      S[mt] = MFMA32(kf, qf, S[mt]);
    }
  }
}
__device__ __forceinline__ void park_q(const bf16x8 (&q)[2][4], unsigned char* smem, int lane) {
  unsigned char* qp = smem + AL_IMP + WAVE * 8192 + lane * 16;
#pragma unroll
  for (int nt = 0; nt < 2; ++nt)
#pragma unroll
    for (int ks = 0; ks < 4; ++ks) *(bf16x8*)(qp + nt * 4096 + ks * 1024) = q[nt][ks];
}
template <int MODE, bool QL>
__device__ __forceinline__ void attn_tile_online(const bf16x8 (&q)[2][4], f32x16 (&O)[2][2], float (&m)[2], float (&l)[2],
                                                 const unsigned char* smem, const unsigned char* kvb, int kv0, int q0, int lane, unsigned selw, bool needmask) {
  const int r = lane & 31, h = lane >> 5;
  const int vloff = vtr_lane_off(lane);
  bool sel[2]; float negm[2];
#pragma unroll
  for (int nt = 0; nt < 2; ++nt) { sel[nt] = (MODE != 2) || ((selw >> nt) & 1u); negm[nt] = (MODE == 2 && !sel[nt]) ? -1e30f : -m[nt]; }
  f32x16 S[2][2];
#pragma unroll
  for (int nt = 0; nt < 2; ++nt)
#pragma unroll
    for (int mt = 0; mt < 2; ++mt)
#pragma unroll
      for (int i = 0; i < 16; ++i) S[nt][mt][i] = negm[nt];
#pragma unroll
  for (int ks = 0; ks < 4; ++ks)
#pragma unroll
    for (int mt = 0; mt < 2; ++mt) {
      const bf16x8 kf = *(const bf16x8*)(kvb + AL_K + swz(32 * mt + r, 2 * ks + h));
#pragma unroll
      for (int nt = 0; nt < 2; ++nt) S[nt][mt] = MFMA32(kf, q[nt][ks], S[nt][mt]);
    }
  if (needmask) {
#pragma unroll
    for (int nt = 0; nt < 2; ++nt)
#pragma unroll
      for (int mt = 0; mt < 2; ++mt) {
        const int dq = q0 + 32 * nt + r - kv0 - 4 * h - 32 * mt;
#pragma unroll
        for (int i = 0; i < 16; ++i) {
          const int cst = (i & 3) + 8 * (i >> 2);
          bool valid;
          if (MODE == 0) valid = (cst <= dq) && (cst > dq - 128);
          else if (MODE == 1) valid = (cst <= dq) && (cst > dq - 512);
          else valid = (cst <= dq);
          S[nt][mt][i] = valid ? S[nt][mt][i] : -INFINITY;
        }
      }
  }
  float mx[2];
#pragma unroll
  for (int nt = 0; nt < 2; ++nt) {
    mx[nt] = -INFINITY;
#pragma unroll
    for (int mt = 0; mt < 2; ++mt) {
      const float a0 = fmaxf(fmaxf(fmaxf(S[nt][mt][0], S[nt][mt][1]), fmaxf(S[nt][mt][2], S[nt][mt][3])), fmaxf(fmaxf(S[nt][mt][4], S[nt][mt][5]), fmaxf(S[nt][mt][6], S[nt][mt][7])));
      const float a1 = fmaxf(fmaxf(fmaxf(S[nt][mt][8], S[nt][mt][9]), fmaxf(S[nt][mt][10], S[nt][mt][11])), fmaxf(fmaxf(S[nt][mt][12], S[nt][mt][13]), fmaxf(S[nt][mt][14], S[nt][mt][15])));
      mx[nt] = fmaxf(mx[nt], fmaxf(a0, a1));
    }
  }
  mx[0] = fmaxf(mx[0], __shfl_xor(mx[0], 32)); mx[1] = fmaxf(mx[1], __shfl_xor(mx[1], 32));
  if (__builtin_amdgcn_ballot_w64(fmaxf(mx[0], mx[1]) > 8.0f) != 0ull) {
#pragma unroll
    for (int nt = 0; nt < 2; ++nt) {
      const float d = (mx[nt] > 8.0f) ? mx[nt] : 0.f;
      const float alpha = __builtin_amdgcn_exp2f(-d);
      m[nt] += d; l[nt] *= alpha;
#pragma unroll
      for (int dt = 0; dt < 2; ++dt) O[nt][dt] = O[nt][dt] * alpha;
#pragma unroll
      for (int mt = 0; mt < 2; ++mt)
#pragma unroll
        for (int i = 0; i < 16; ++i) S[nt][mt][i] -= d;
    }
  }
#pragma unroll
  for (int nt = 0; nt < 2; ++nt) {
    float lsum = 0.f;
#pragma unroll
    for (int mt = 0; mt < 2; ++mt)
#pragma unroll
      for (int i = 0; i < 16; ++i) { const float pp = __builtin_amdgcn_exp2f(S[nt][mt][i]); S[nt][mt][i] = pp; lsum += pp; }
    l[nt] += lsum;
  }
#pragma unroll
  for (int mt = 0; mt < 2; ++mt)
#pragma unroll
    for (int s = 0; s < 2; ++s) {
      FragU pf[2];
#pragma unroll
      for (int nt = 0; nt < 2; ++nt) {
        pf[nt].u.x = pack2(S[nt][mt][8 * s + 0], S[nt][mt][8 * s + 1]); pf[nt].u.y = pack2(S[nt][mt][8 * s + 2], S[nt][mt][8 * s + 3]);
        pf[nt].u.z = pack2(S[nt][mt][8 * s + 4], S[nt][mt][8 * s + 5]); pf[nt].u.w = pack2(S[nt][mt][8 * s + 6], S[nt][mt][8 * s + 7]);
      }
#pragma unroll
      for (int dt = 0; dt < 2; ++dt) {
        const bf16x8 vf = vtr_frag(kvb + AL_VT, vloff, dt, mt, s);
#pragma unroll
        for (int nt = 0; nt < 2; ++nt) O[nt][dt] = MFMA32(vf, pf[nt].b, O[nt][dt]);
      }
    }
}

__device__ __forceinline__ void load_q(bf16x8 (&q)[2][4], const bf16_t* qbase  , int lane) {
  const int r = lane & 31, h = lane >> 5;
#pragma unroll
  for (int nt = 0; nt < 2; ++nt)
#pragma unroll
    for (int ks = 0; ks < 4; ++ks) q[nt][ks] = *(const bf16x8*)(qbase + (size_t)(32 * nt + r) * LDP + 16 * ks + 8 * h);
}
__device__ __forceinline__ void zero_O(f32x16 (&O)[2][2]) {
#pragma unroll
  for (int a = 0; a < 2; ++a)
#pragma unroll
    for (int b = 0; b < 2; ++b)
#pragma unroll
      for (int i = 0; i < 16; ++i) O[a][b][i] = 0.f;
}

template <int MODE, bool QL>
__device__ __forceinline__ void attn_loop(const bf16x8 (&q)[2][4], f32x16 (&O)[2][2], float (&m)[2], float (&l)[2], unsigned char* smem,
                                          const bf16_t* kbase, const bf16_t* vbase, long stride, int t0, int t1, int q0, int lane) {
  unsigned uni[4] = {0xffffffffu, 0xffffffffu, 0xffffffffu, 0xffffffffu};
  if (MODE == 2) {
    const unsigned* up = (const unsigned*)(smem + AL_UNI);
    uni[0] = up[0]; uni[1] = up[1]; uni[2] = up[2]; uni[3] = up[3];
  }
  auto bit = [&](int t) -> bool {
    const unsigned wv = (t < 32) ? uni[0] : (t < 64) ? uni[1] : (t < 96) ? uni[2] : uni[3];
    return (wv >> (t & 31)) & 1u;
  };
  auto next_tile = [&](int t) -> int { if (MODE == 2) { while (t < t1 && !bit(t)) ++t; } return t; };
  auto run_tile = [&](int cur, const unsigned char* kvb) {
    unsigned selw = 0;
    if (MODE == 2) {
      const unsigned* sm = (const unsigned*)(smem + AL_SEL);
      const int r = lane & 31;
      selw = ((sm[r * 4 + (cur >> 5)] >> (cur & 31)) & 1u) | (((sm[(32 + r) * 4 + (cur >> 5)] >> (cur & 31)) & 1u) << 1);
    }
    const int qt_ = q0 >> 6;
    const bool needmask = (MODE == 0) ? (cur != qt_ - 1) : (MODE == 1) ? (cur == qt_ || cur == qt_ - 8) : (cur == qt_);
    attn_tile_online<MODE, QL>(q, O, m, l, smem, kvb, cur * 64, q0, lane, selw, needmask);
  };
  int nxt = next_tile(t0);
  KVRegs R;
  {
    if (nxt >= t1) return;
    kv_load(R, kbase, vbase, stride, nxt * 64, true);
    __syncthreads();
    kv_store(R, smem, true);
    int cur = nxt, bsel = 0;
    nxt = next_tile(cur + 1);
    if (nxt < t1) kv_load(R, kbase, vbase, stride, nxt * 64, true);
    __syncthreads();
    for (;;) {
      run_tile(cur, smem + bsel * KVB);
      if (nxt >= t1) break;
      kv_store(R, smem + (bsel ^ 1) * KVB, true);
      cur = nxt;
      nxt = next_tile(cur + 1);
      if (nxt < t1) kv_load(R, kbase, vbase, stride, nxt * 64, true);
      __syncthreads();
      bsel ^= 1;
    }
  }
}

template <bool FIRST>
__device__ __forceinline__ void y_accum(bf16_t* ybase_in  , const f32x16 (&O)[2][2], const float (&sc)[2], int lane_in) {
  int lane = lane_in; asm volatile("" : "+v"(lane));
  bf16_t* ybase = ybase_in;
  const int r = lane & 31, h = lane >> 5;
#pragma unroll
  for (int nt = 0; nt < 2; ++nt)
#pragma unroll
    for (int dt = 0; dt < 2; ++dt)
#pragma unroll
      for (int g4 = 0; g4 < 4; ++g4) {
        u32x2* ptr = (u32x2*)(ybase + (size_t)(32 * nt + r) * LDP + 32 * dt + 8 * g4 + 4 * h);
        float v0 = O[nt][dt][4 * g4] * sc[nt], v1 = O[nt][dt][4 * g4 + 1] * sc[nt], v2 = O[nt][dt][4 * g4 + 2] * sc[nt], v3 = O[nt][dt][4 * g4 + 3] * sc[nt];
        if (!FIRST) {
          const u32x2 old = *ptr;
          v0 += __uint_as_float(old.x << 16); v1 += __uint_as_float(old.x & 0xffff0000u);
          v2 += __uint_as_float(old.y << 16); v3 += __uint_as_float(old.y & 0xffff0000u);
        }
        u32x2 o; o.x = pack2(v0, v1); o.y = pack2(v2, v3);
        *ptr = o;
      }
}

__device__ __forceinline__ void swa_unit(const Params& p, int l, int unit, unsigned char* smem) {
  const int lane = TIDX & 63, w = WAVE;
  const int qt = unit & 127, bg = unit >> 7, b = bg >> 1, g = bg & 1, head = g * 4 + w, q0 = qt * 64;
  bf16_t* P = (bf16_t*)(p.ws + OFF_P);
  bf16_t* rowb = P + (size_t)b * T_SEQ * LDP;
  bf16x8 q[2][4];
  load_q(q, rowb + (size_t)q0 * LDP + C_AQ + head * 64, lane);
  f32x16 O[2][2]; zero_O(O);
  float m[2] = {0.f, 0.f}, lsum[2] = {0.f, 0.f};
  const int t0 = (q0 >= 128) ? (q0 - 128) / 64 : 0, t1 = qt + 1;
  attn_loop<0, false>(q, O, m, lsum, smem, rowb + C_AK + g * 64, rowb + C_AV + g * 64, LDP, t0, t1, q0, lane);
  const float sink = p.in[I_SINK][l * 8 + head] * 1.4426950408889634f;
  float sc[2];
#pragma unroll
  for (int nt = 0; nt < 2; ++nt) {
    const float lt = lsum[nt] + __shfl_xor(lsum[nt], 32);
    const float mf = fmaxf(m[nt], sink);
    const float e = __builtin_amdgcn_exp2f(m[nt] - mf);
    const float den = lt * e + __builtin_amdgcn_exp2f(sink - mf);
    sc[nt] = e / fmaxf(den, 1e-30f);
  }
  y_accum<true>(rowb + (size_t)q0 * LDP + C_AQ + head * 64, O, sc, lane);
}

__device__ __forceinline__ int wave_max_i32(int v) {
  v = max(v, __builtin_amdgcn_update_dpp(v, v, 0x111, 0xf, 0xf, false));
  v = max(v, __builtin_amdgcn_update_dpp(v, v, 0x112, 0xf, 0xf, false));
  v = max(v, __builtin_amdgcn_update_dpp(v, v, 0x114, 0xf, 0xf, false));
  v = max(v, __builtin_amdgcn_update_dpp(v, v, 0x118, 0xf, 0xf, false));
  v = max(v, __builtin_amdgcn_update_dpp(v, v, 0x142, 0xa, 0xf, false));
  v = max(v, __builtin_amdgcn_update_dpp(v, v, 0x143, 0xc, 0xf, false));
  return __builtin_amdgcn_readlane(v, 63);
}
__device__ __forceinline__ void nsa_unit(const Params& p, int l, int unit, unsigned char* smem, int ycol = C_CQ) {
  const int lane = TIDX & 63, w = WAVE, r = lane & 31, h = lane >> 5;
  const int qt = 127 - (unit >> 3), bg = unit & 7, b = bg >> 1, g = bg & 1, head = g * 4 + w, q0 = qt * 64, cur = qt;
  bf16_t* P = (bf16_t*)(p.ws + OFF_P);
  bf16_t* rowb = P + (size_t)b * T_SEQ * LDP;
  const bf16_t* kcmp = (const bf16_t*)(p.ws + OFF_KCMP) + (size_t)bg * 512 * 64;
  const bf16_t* vcmp = (const bf16_t*)(p.ws + OFF_VCMP) + (size_t)bg * 512 * 64;
  bf16x8 q[2][4];
  load_q(q, rowb + (size_t)q0 * LDP + C_CQ + head * 64, lane);
  auto gate_of = [&](int i, int nt) -> float { int rr = r; asm volatile("" : "+v"(rr)); return sigmoidf_(bf2f(rowb[(size_t)(q0 + 32 * nt + rr) * LDP + C_CG + head * 3 + i])); };
  bf16_t* ybase = rowb + (size_t)q0 * LDP + ycol + head * 64;

  {
    unsigned* imp = (unsigned*)(smem + AL_IMP);
    for (int i = TIDX; i < 64 * 129; i += NTHREADS) imp[i] = 0u;
    unsigned* sm = (unsigned*)(smem + AL_SEL);
    for (int i = TIDX; i < 64 * 4 + 4; i += NTHREADS) sm[i] = 0u;
  }
  const int nmax = (q0 + 32) >> 4;
  const int nct = (nmax >> 6) + 1;
  const bool do_imp = (cur >= 16);
  float m[2] = {-1e30f, -1e30f}, ls[2] = {0.f, 0.f};
  {
    KVRegs R;
    kv_load(R, kcmp, vcmp, 64, 0, false);
    for (int t = 0; t < nct; ++t) {
      __syncthreads();
      kv_store(R, smem, false);
      __syncthreads();
      if (t + 1 < nct) kv_load(R, kcmp, vcmp, 64, (t + 1) * 64, false);
#pragma unroll
      for (int nt = 0; nt < 2; ++nt) {
        __builtin_amdgcn_sched_barrier(0);
        f32x16 S[2];
        compute_S<false>(q[nt], nt, S, smem, lane);
        __builtin_amdgcn_sched_barrier(0);
        const int tq = q0 + 32 * nt + r;
        float mx = -1e30f;
#pragma unroll
        for (int mt = 0; mt < 2; ++mt)
#pragma unroll
          for (int i = 0; i < 16; ++i) {
            const int dn = tq - 31 - 16 * (t * 64 + 32 * mt + 4 * h);
            const float sv = (16 * ((i & 3) + 8 * (i >> 2)) <= dn) ? S[mt][i] : -1e30f;
            S[mt][i] = sv; mx = fmaxf(mx, sv);
          }
        mx = fmaxf(mx, __shfl_xor(mx, 32));
        const float mnew = fmaxf(m[nt], mx);
        const float alpha = __builtin_amdgcn_exp2f(m[nt] - mnew);
        m[nt] = mnew;
        float s1 = 0.f;
#pragma unroll
        for (int mt = 0; mt < 2; ++mt)
#pragma unroll
          for (int i = 0; i < 16; ++i) s1 += (S[mt][i] > -1e29f) ? __builtin_amdgcn_exp2f(S[mt][i] - mnew) : 0.f;
        ls[nt] = ls[nt] * alpha + s1;
      }
    }
  }
  float rl[2];
#pragma unroll
  for (int nt = 0; nt < 2; ++nt) { const float lt = ls[nt] + __shfl_xor(ls[nt], 32); rl[nt] = 1.f / fmaxf(lt, 1e-30f); }
  {
    f32x16 O[2][2]; zero_O(O);
    KVRegs R;
    kv_load(R, kcmp, vcmp, 64, 0, true);
    for (int t = 0; t < nct; ++t) {
      __syncthreads();
      kv_store(R, smem, true);
      __syncthreads();
      if (t + 1 < nct) kv_load(R, kcmp, vcmp, 64, (t + 1) * 64, true);
#pragma unroll
      for (int nt = 0; nt < 2; ++nt) {
        const int tq = q0 + 32 * nt + r;
        const int vloff = vtr_lane_off(lane);
        unsigned* imp = (unsigned*)(smem + AL_IMP) + (32 * nt + r) * 129;
#pragma unroll
        for (int mt = 0; mt < 2; ++mt) {
          __builtin_amdgcn_sched_barrier(0);
          f32x16 S;
#pragma unroll
          for (int i = 0; i < 16; ++i) S[i] = 0.f;
#pragma unroll
          for (int ks = 0; ks < 4; ++ks) {
            const bf16x8 kf = *(const bf16x8*)(smem + AL_K + swz(32 * mt + r, 2 * ks + h));
            S = MFMA32(kf, q[nt][ks], S);
          }
          __builtin_amdgcn_sched_barrier(0);
#pragma unroll
          for (int i = 0; i < 16; ++i) {
            const int dn = tq - 31 - 16 * (t * 64 + 32 * mt + 4 * h);
            S[i] = (16 * ((i & 3) + 8 * (i >> 2)) <= dn) ? __builtin_amdgcn_exp2f(S[i] - m[nt]) * rl[nt] : 0.f;
          }
          if (do_imp) {
#pragma unroll
            for (int g4 = 0; g4 < 4; ++g4) {
              const int sb = (t * 64 + 32 * mt + 8 * g4 + 4 * h) >> 2;
              const float s4 = (S[4 * g4] + S[4 * g4 + 1]) + (S[4 * g4 + 2] + S[4 * g4 + 3]);
              atomicAdd(&imp[sb], (unsigned)(s4 * 16777216.f + 0.5f));
              if (sb + 1 < 128) atomicAdd(&imp[sb + 1], (unsigned)(S[4 * g4 + 3] * 16777216.f + 0.5f));
            }
          }
#pragma unroll
          for (int s2 = 0; s2 < 2; ++s2) {
            FragU pf;
            pf.u.x = pack2(S[8 * s2 + 0], S[8 * s2 + 1]); pf.u.y = pack2(S[8 * s2 + 2], S[8 * s2 + 3]);
            pf.u.z = pack2(S[8 * s2 + 4], S[8 * s2 + 5]); pf.u.w = pack2(S[8 * s2 + 6], S[8 * s2 + 7]);
#pragma unroll
            for (int dt = 0; dt < 2; ++dt) O[nt][dt] = MFMA32(vtr_frag(smem + AL_VT, vloff, dt, mt, s2), pf.b, O[nt][dt]);
          }
        }
      }
    }
    float sc[2] = {gate_of(0, 0), gate_of(0, 1)};
    y_accum<true>(ybase, O, sc, lane);
  }
  __syncthreads();
  {
    unsigned* sm = (unsigned*)(smem + AL_SEL);
    unsigned* un = (unsigned*)(smem + AL_UNI);
    const unsigned* imp = (const unsigned*)(smem + AL_IMP);
    for (int qi = 0; qi < 16; qi += 2) {
      unsigned mk[2][4];
      int v0[2], v1[2];
#pragma unroll
      for (int u = 0; u < 2; ++u) {
        const int qq = w * 16 + qi + u;
        mk[u][0] = mk[u][1] = mk[u][2] = mk[u][3] = 0u;
        if (!do_imp) {
          mk[u][0] = (cur >= 31) ? 0xffffffffu : ((1u << (cur + 1)) - 1u);
          v0[u] = v1[u] = -1;
        } else {
          v0[u] = (lane >= 1 && lane <= cur - 2) ? (int)imp[qq * 129 + lane] : -1;
          v1[u] = (lane + 64 <= cur - 2) ? (int)imp[qq * 129 + lane + 64] : -1;
          const int fs[3] = {0, cur - 1, cur};
#pragma unroll
          for (int k = 0; k < 3; ++k) {
            const int sb = fs[k];
            if (sb < 32) mk[u][0] |= 1u << sb; else if (sb < 64) mk[u][1] |= 1u << (sb - 32); else if (sb < 96) mk[u][2] |= 1u << (sb - 64); else mk[u][3] |= 1u << (sb - 96);
          }
        }
      }
      if (do_imp) {
        for (int rnd = 0; rnd < 13; ++rnd) {
          int mx[2];
#pragma unroll
          for (int u = 0; u < 2; ++u) mx[u] = wave_max_i32(max(v0[u], v1[u]));
#pragma unroll
          for (int u = 0; u < 2; ++u) {
            const unsigned long long b0 = __ballot(v0[u] == mx[u]);
            int sb;
            if (b0) { const int sl = __ffsll((long long)b0) - 1; sb = sl; if (lane == sl) v0[u] = -1; }
            else { const unsigned long long b1 = __ballot(v1[u] == mx[u]); const int sl = __ffsll((long long)b1) - 1; sb = sl + 64; if (lane == sl) v1[u] = -1; }
            if (sb < 32) mk[u][0] |= 1u << sb; else if (sb < 64) mk[u][1] |= 1u << (sb - 32); else if (sb < 96) mk[u][2] |= 1u << (sb - 64); else mk[u][3] |= 1u << (sb - 96);
          }
        }
      }
      if (lane == 0) {
#pragma unroll
        for (int u = 0; u < 2; ++u) {
          const int qq = w * 16 + qi + u;
          sm[qq * 4 + 0] = mk[u][0]; sm[qq * 4 + 1] = mk[u][1]; sm[qq * 4 + 2] = mk[u][2]; sm[qq * 4 + 3] = mk[u][3];
          atomicOr(&un[0], mk[u][0]); atomicOr(&un[1], mk[u][1]); atomicOr(&un[2], mk[u][2]); atomicOr(&un[3], mk[u][3]);
        }
      }
    }
  }
  __syncthreads();
  {
    f32x16 O[2][2]; zero_O(O);
    float m2[2] = {0.f, 0.f}, l2[2] = {0.f, 0.f};
    attn_loop<2, false>(q, O, m2, l2, smem, rowb + C_CKS + g * 64, rowb + C_CVS + g * 64, LDP, 0, cur + 1, q0, lane);
    float sc[2];
#pragma unroll
    for (int nt = 0; nt < 2; ++nt) { const float lt = l2[nt] + __shfl_xor(l2[nt], 32); sc[nt] = gate_of(1, nt) / fmaxf(lt, 1e-30f); }
    y_accum<false>(ybase, O, sc, lane);
  }
  {
    f32x16 O[2][2]; zero_O(O);
    float m2[2] = {0.f, 0.f}, l2[2] = {0.f, 0.f};
    const int t0 = (q0 >= 512) ? (q0 - 512) / 64 : 0;
    attn_loop<1, false>(q, O, m2, l2, smem, rowb + C_CKW + g * 64, rowb + C_CVW + g * 64, LDP, t0, cur + 1, q0, lane);
    float sc[2];
#pragma unroll
    for (int nt = 0; nt < 2; ++nt) { const float lt = l2[nt] + __shfl_xor(l2[nt], 32); sc[nt] = gate_of(2, nt) / fmaxf(lt, 1e-30f); }
    y_accum<false>(ybase, O, sc, lane);
  }
  __syncthreads();
}

__device__ __forceinline__ float ret_log2g(int h) { return log2f(1.f - exp2f(-5.f - (float)h)); }

__device__ __forceinline__ void ret_state_unit(const Params& p, int unit, unsigned char* smem) {
  const int t = TIDX, lane = t & 63, w = WAVE, r = lane & 31, hh = lane >> 5;
  const int n = unit & 63, bh = unit >> 6, b = bh >> 2, h = bh & 3;
  const bf16_t* P = (const bf16_t*)(p.ws + OFF_P);
  const bf16_t* rowb = P + ((size_t)b * T_SEQ + n * 128) * LDP;
  bf16_t* Vt = (bf16_t*)smem;
  bf16_t* Kt = (bf16_t*)(smem + 34816);
  const float l2g = ret_log2g(h);
  __syncthreads();
#pragma unroll
  for (int i = 0; i < 8; ++i) {
    const int idx = t + 256 * i, tok = idx >> 4, c = idx & 15;
    const u32x4 v = *(const u32x4*)(rowb + (size_t)tok * LDP + C_DV + h * 128 + c * 8);
#pragma unroll
    for (int j = 0; j < 4; ++j) {
      Vt[(8 * c + 2 * j) * 136 + tok] = (bf16_t)(v[j] & 0xffffu);
      Vt[(8 * c + 2 * j + 1) * 136 + tok] = (bf16_t)(v[j] >> 16);
    }
  }
#pragma unroll
  for (int i = 0; i < 4; ++i) {
    const int idx = t + 256 * i, tok = idx >> 3, c = idx & 7;
    const u32x4 v = *(const u32x4*)(rowb + (size_t)tok * LDP + C_DK + h * 64 + c * 8);
    const float z = exp2f((float)(127 - tok) * l2g);
#pragma unroll
    for (int j = 0; j < 4; ++j) {
      Kt[(8 * c + 2 * j) * 136 + tok] = f2bf(__uint_as_float(v[j] << 16) * z);
      Kt[(8 * c + 2 * j + 1) * 136 + tok] = f2bf(__uint_as_float(v[j] & 0xffff0000u) * z);
    }
  }
  __syncthreads();
  f32x16 acc[2];
#pragma unroll
  for (int ct = 0; ct < 2; ++ct)
#pragma unroll
    for (int i = 0; i < 16; ++i) acc[ct][i] = 0.f;
#pragma unroll
  for (int ks = 0; ks < 8; ++ks) {
    const bf16x8 a = *(const bf16x8*)(Vt + (32 * w + r) * 136 + 16 * ks + 8 * hh);
#pragma unroll
    for (int ct = 0; ct < 2; ++ct) {
      const bf16x8 bb = *(const bf16x8*)(Kt + (32 * ct + r) * 136 + 16 * ks + 8 * hh);
      acc[ct] = MFMA32(a, bb, acc[ct]);
    }
  }
  bf16_t* RT = (bf16_t*)(p.ws + OFF_RT) + ((size_t)bh * 64 + n) * 8192;
#pragma unroll
  for (int ct = 0; ct < 2; ++ct)
#pragma unroll
    for (int i = 0; i < 16; ++i) {
      const int dv = 32 * w + (i & 3) + 8 * (i >> 2) + 4 * hh;
      RT[dv * 64 + 32 * ct + r] = f2bf(acc[ct][i]);
    }
}

__device__ __forceinline__ void ret_scan(const Params& p) {
  bf16_t* RT = (bf16_t*)(p.ws + OFF_RT);
  for (int i = blockIdx.x * NTHREADS + TIDX; i < 16 * 8192; i += gridDim.x * NTHREADS) {
    const int bh = i >> 13, e = i & 8191, h = bh & 3;
    const float decay = exp2f(128.f * ret_log2g(h));
    bf16_t* ptr = RT + (size_t)bh * 64 * 8192 + e;
    float rr = 0.f;
    for (int n0 = 0; n0 < 64; n0 += 16) {
      float v[16];
#pragma unroll
      for (int j = 0; j < 16; ++j) v[j] = bf2f(ptr[(size_t)(n0 + j) * 8192]);
#pragma unroll
      for (int j = 0; j < 16; ++j) { ptr[(size_t)(n0 + j) * 8192] = f2bf(rr); rr = rr * decay + v[j]; }
    }
  }
}

__device__ __forceinline__ void ret_out_unit(const Params& p, int l, int unit, unsigned char* smem, int ocol = C_DG) {
  const int t = TIDX, lane = t & 63, w = WAVE, r = lane & 31, hh = lane >> 5;
  const int n = unit & 63, bh = unit >> 6, b = bh >> 2, h = bh & 3;
  bf16_t* P = (bf16_t*)(p.ws + OFF_P);
  bf16_t* rowb = P + ((size_t)b * T_SEQ + n * 128) * LDP;
  const bf16_t* RT = (const bf16_t*)(p.ws + OFF_RT) + ((size_t)bh * 64 + n) * 8192;
  unsigned char* Ks = smem;
  bf16_t* Vt = (bf16_t*)(smem + 16384);
  unsigned char* Rs = smem + 50176;
  const float l2g = ret_log2g(h);
  __syncthreads();
#pragma unroll
  for (int i = 0; i < 4; ++i) {
    const int idx = t + 256 * i, row = idx >> 3, c = idx & 7;
    *(u32x4*)(Ks + swz(row, c)) = *(const u32x4*)(rowb + (size_t)row * LDP + C_DK + h * 64 + c * 8);
    *(u32x4*)(Rs + swz(row, c)) = *(const u32x4*)(RT + row * 64 + c * 8);
  }
#pragma unroll
  for (int i = 0; i < 8; ++i) {
    const int idx = t + 256 * i, tok = idx >> 4, c = idx & 15;
    const u32x4 v = *(const u32x4*)(rowb + (size_t)tok * LDP + C_DV + h * 128 + c * 8);
#pragma unroll
    for (int j = 0; j < 4; ++j) {
      Vt[(8 * c + 2 * j) * 132 + tok] = (bf16_t)(v[j] & 0xffffu);
      Vt[(8 * c + 2 * j + 1) * 132 + tok] = (bf16_t)(v[j] >> 16);
    }
  }
  const int cq = 32 * w + r;
  bf16x8 qf[4];
#pragma unroll
  for (int ks = 0; ks < 4; ++ks) qf[ks] = *(const bf16x8*)(rowb + (size_t)cq * LDP + C_DQ + h * 64 + 16 * ks + 8 * hh);
  __syncthreads();
  f32x16 O[4];
#pragma unroll
  for (int dt = 0; dt < 4; ++dt) {
#pragma unroll
    for (int i = 0; i < 16; ++i) O[dt][i] = 0.f;
#pragma unroll
    for (int ks = 0; ks < 4; ++ks) {
      const bf16x8 a = *(const bf16x8*)(Rs + swz(32 * dt + r, 2 * ks + hh));
      O[dt] = MFMA32(a, qf[ks], O[dt]);
    }
  }
  const float xi = exp2f((float)(cq + 1) * l2g);
#pragma unroll
  for (int dt = 0; dt < 4; ++dt) O[dt] = O[dt] * xi;
  for (int mt = 0; mt <= w; ++mt) {
    f32x16 S;
#pragma unroll
    for (int i = 0; i < 16; ++i) S[i] = 0.f;
#pragma unroll
    for (int ks = 0; ks < 4; ++ks) {
      const bf16x8 a = *(const bf16x8*)(Ks + swz(32 * mt + r, 2 * ks + hh));
      S = MFMA32(a, qf[ks], S);
    }
    const int dbase = cq - 32 * mt - 4 * hh;
#pragma unroll
    for (int i = 0; i < 16; ++i) {
      const int d = dbase - ((i & 3) + 8 * (i >> 2));
      S[i] = (d >= 0) ? S[i] * exp2f((float)d * l2g) : 0.f;
    }
#pragma unroll
    for (int s = 0; s < 2; ++s) {
      FragU pf;
      pf.u.x = pack2(S[8 * s + 0], S[8 * s + 1]); pf.u.y = pack2(S[8 * s + 2], S[8 * s + 3]);
      pf.u.z = pack2(S[8 * s + 4], S[8 * s + 5]); pf.u.w = pack2(S[8 * s + 6], S[8 * s + 7]);
#pragma unroll
      for (int dt = 0; dt < 4; ++dt) {
        const bf16_t* a = Vt + (32 * dt + r) * 132 + 32 * mt + 16 * s + 4 * hh;
        const u32x2 lo = *(const u32x2*)a, hi = *(const u32x2*)(a + 8);
        FragU vf; vf.u.x = lo.x; vf.u.y = lo.y; vf.u.z = hi.x; vf.u.w = hi.y;
        O[dt] = MFMA32(vf.b, pf.b, O[dt]);
      }
    }
  }
  float s1 = 0.f;
#pragma unroll
  for (int dt = 0; dt < 4; ++dt)
#pragma unroll
    for (int i = 0; i < 16; ++i) s1 += O[dt][i];
  s1 += __shfl_xor(s1, 32);
  const float mu = s1 * (1.f / 128.f);
  float s2 = 0.f;
#pragma unroll
  for (int dt = 0; dt < 4; ++dt)
#pragma unroll
    for (int i = 0; i < 16; ++i) { const float d = O[dt][i] - mu; s2 += d * d; }
  s2 += __shfl_xor(s2, 32);
  const float rstd = rsqrtf(s2 * (1.f / 128.f) + 1e-6f);
  const float* gn = p.in[I_RETG] + (size_t)l * 512 + h * 128;
  bf16_t* yrow = rowb + (size_t)cq * LDP + C_DG + h * 128;
#pragma unroll
  for (int dt = 0; dt < 4; ++dt)
#pragma unroll
    for (int g4 = 0; g4 < 4; ++g4) {
      const int dv = 32 * dt + 8 * g4 + 4 * hh;
      const u32x2 gt = *(const u32x2*)(yrow + dv);
      const f32x4 gv = *(const f32x4*)(gn + dv);
      const float g0 = __uint_as_float(gt.x << 16), g1 = __uint_as_float(gt.x & 0xffff0000u);
      const float g2 = __uint_as_float(gt.y << 16), g3 = __uint_as_float(gt.y & 0xffff0000u);
      u32x2 o;
      o.x = pack2((O[dt][4 * g4 + 0] - mu) * rstd * gv[0] * siluf_(g0), (O[dt][4 * g4 + 1] - mu) * rstd * gv[1] * siluf_(g1));
      o.y = pack2((O[dt][4 * g4 + 2] - mu) * rstd * gv[2] * siluf_(g2), (O[dt][4 * g4 + 3] - mu) * rstd * gv[3] * siluf_(g3));
      *(u32x2*)(yrow + dv + (ocol - C_DG)) = o;
    }
}

__device__ __forceinline__ void conv_item(const Params& p, int l, int item) {
  bf16_t* P = (bf16_t*)(p.ws + OFF_P);
  const float* cw = p.in[I_CONVW] + (size_t)l * 1536;
  for (int k = TIDX; k < 32 * 64; k += NTHREADS) {
    const int tok = item * 32 + (k >> 6), c = k & 63, pos = tok & (T_SEQ - 1);
    const bf16_t* row = P + (size_t)tok * LDP;
    float z[3][8];
#pragma unroll
    for (int d = 0; d < 3; ++d) {
      if (pos >= d) {
        const u32x4 xv = *(const u32x4*)(row - (size_t)d * LDP + C_BX + c * 8);
        const u32x4 cv = *(const u32x4*)(row - (size_t)d * LDP + C_BC + c * 8);
#pragma unroll
        for (int j = 0; j < 4; ++j) {
          z[d][2 * j] = __uint_as_float(xv[j] << 16) * __uint_as_float(cv[j] << 16);
          z[d][2 * j + 1] = __uint_as_float(xv[j] & 0xffff0000u) * __uint_as_float(cv[j] & 0xffff0000u);
        }
      } else {
#pragma unroll
        for (int j = 0; j < 8; ++j) z[d][j] = 0.f;
      }
    }
    const u32x4 bv = *(const u32x4*)(row + C_BB + c * 8);
    float y[8];
#pragma unroll
    for (int j = 0; j < 8; ++j) {
      const int ch = c * 8 + j;
      const float bj = (j & 1) ? __uint_as_float(bv[j >> 1] & 0xffff0000u) : __uint_as_float(bv[j >> 1] << 16);
      y[j] = bj * (cw[ch] * z[2][j] + cw[512 + ch] * z[1][j] + cw[1024 + ch] * z[0][j]);
    }
    u32x4 o; o.x = pack2(y[0], y[1]); o.y = pack2(y[2], y[3]); o.z = pack2(y[4], y[5]); o.w = pack2(y[6], y[7]);
    *(u32x4*)(P + (size_t)tok * LDP + C_BB + c * 8) = o;
  }
}

__device__ __forceinline__ void compress2(const Params& p, int l) {
  const int lane = TIDX & 63;
  const int gw = blockIdx.x * 4 + WAVE, nw = gridDim.x * 4;
  for (int task = gw; task < 2048; task += nw) {
    const int kv = task >> 10, row0 = (task & 1023) * 4;
    const bf16_t* hid = (const bf16_t*)(p.ws + OFF_CMPH) + ((size_t)kv * 4096 + row0) * 256;
    const float* w2 = p.in[kv ? I_WV2 : I_WK2] + (size_t)l * 256 * 64;
    float acc[4] = {0.f, 0.f, 0.f, 0.f};
    for (int k8 = 0; k8 < 32; k8 += 2) {
      u32x4 hv[4][2]; float wv[16];
#pragma unroll
      for (int rr = 0; rr < 4; ++rr)
#pragma unroll
        for (int u = 0; u < 2; ++u) hv[rr][u] = *(const u32x4*)(hid + rr * 256 + (k8 + u) * 8);
#pragma unroll
      for (int u = 0; u < 16; ++u) wv[u] = w2[(k8 * 8 + u) * 64 + lane];
#pragma unroll
      for (int rr = 0; rr < 4; ++rr)
#pragma unroll
        for (int u = 0; u < 2; ++u)
#pragma unroll
          for (int j = 0; j < 4; ++j) {
            acc[rr] += __uint_as_float(hv[rr][u][j] << 16) * wv[u * 8 + 2 * j];
            acc[rr] += __uint_as_float(hv[rr][u][j] & 0xffff0000u) * wv[u * 8 + 2 * j + 1];
          }
    }
#pragma unroll
    for (int rr = 0; rr < 4; ++rr) {
      float a = acc[rr];
      if (kv == 0) {
        float ss = a * a;
#pragma unroll
        for (int o = 32; o >= 1; o >>= 1) ss += __shfl_xor(ss, o);
        a = a * rsqrtf(ss * (1.f / 64.f) + 1e-6f) * p.in[I_NSAKG][l * 192 + lane];
      }
      bf16_t* dst = (bf16_t*)(p.ws + (kv ? OFF_VCMP : OFF_KCMP)) + (size_t)(row0 + rr) * 64 + lane;
      *dst = f2bf(a);
    }
  }
}

#define XB_TMO      128
#define XB_XCNT(j)  (256  + 64 * (j))
#define XB_XSUB(j)  (1280 + 64 * (j))
#define XB_XGEN(j)  (2304 + 64 * (j))
#define XB_TOP      3328
#define XB_TOPGEN   3392
#define XCD_BAR_WORDS 3456
#define XB_SPIN_CAP (1u << 20)
__device__ __forceinline__ unsigned xb_ld(unsigned* p)              { return __hip_atomic_load(p, __ATOMIC_RELAXED, __HIP_MEMORY_SCOPE_AGENT); }
__device__ __forceinline__ unsigned xb_add(unsigned* p, unsigned v) { return __hip_atomic_fetch_add(p, v, __ATOMIC_RELAXED, __HIP_MEMORY_SCOPE_AGENT); }
__device__ __forceinline__ unsigned xb_xcc_id() { return (unsigned)__builtin_amdgcn_s_getreg((3 << 11) | 20) & 0xFu; }
#define XB_SPIN(cond, bar) do { unsigned _sp = 0; while (cond) { __builtin_amdgcn_s_sleep(1); \
    if ((++_sp & 255u) == 0u) { if (xb_ld(&(bar)[XB_TMO])) break; if (_sp > XB_SPIN_CAP) { atomicAdd(&(bar)[XB_TMO], 1u); break; } } } } while (0)
struct XcdBarrier { unsigned* bar; unsigned x; volatile LDS_AS unsigned* st; };
__device__ __forceinline__ XcdBarrier xcd_barrier_post(unsigned* bar, volatile LDS_AS unsigned* st) {
  XcdBarrier b; b.bar = bar; b.x = xb_xcc_id(); b.st = st;
  if (TIDX == 0) (void)xb_add(&bar[XB_XCNT(b.x)], 1u);
  return b;
}
__device__ __forceinline__ void xcd_barrier_complete(unsigned* bar, unsigned x, unsigned& nloc, unsigned& nx) {
  const unsigned G = gridDim.x * gridDim.y * gridDim.z;
  unsigned sum, cnt, mine, sp = 0u;
  for (;;) {
    sum = 0u; cnt = 0u; mine = 0u;
#pragma unroll
    for (unsigned j = 0; j < 16; ++j) { const unsigned c = xb_ld(&bar[XB_XCNT(j)]); sum += c; cnt += (c > 0u) ? 1u : 0u; mine = (j == x) ? c : mine; }
    if (sum == G) break;
    __builtin_amdgcn_s_sleep(1);
    if ((++sp & 255u) == 0u) { if (xb_ld(&bar[XB_TMO])) break; if (sp > XB_SPIN_CAP) { atomicAdd(&bar[XB_TMO], 1u); break; } }
  }
  nloc = mine > 0u ? mine : 1u; nx = cnt > 0u ? cnt : 1u;
}
__device__ __forceinline__ void xcd_barrier(const XcdBarrier& b) {
  asm volatile("s_waitcnt vmcnt(0)" ::: "memory");
  __syncthreads();
  if (TIDX == 0) {
    unsigned* bar = b.bar;
    __builtin_amdgcn_s_waitcnt(0);
    unsigned nloc = b.st[0], nx = b.st[1];
    if (nloc == 0u) { xcd_barrier_complete(bar, b.x, nloc, nx); b.st[0] = nloc; b.st[1] = nx; }
    const unsigned old = xb_add(&bar[XB_XSUB(b.x)], 1u);
    const unsigned gen = old / nloc;
    if (old + 1u == (gen + 1u) * nloc) {
      __builtin_amdgcn_fence(__ATOMIC_RELEASE, "agent");
      asm volatile("s_waitcnt vmcnt(0)" ::: "memory");
      const unsigned og = xb_add(&bar[XB_TOP], 1u);
      const unsigned tg = og / nx;
      if (og + 1u == (tg + 1u) * nx) xb_add(&bar[XB_TOPGEN], 1u);
      else XB_SPIN(xb_ld(&bar[XB_TOPGEN]) == tg, bar);
      __builtin_amdgcn_fence(__ATOMIC_ACQUIRE, "agent");
      xb_add(&bar[XB_XGEN(b.x)], 1u);
      asm volatile("s_waitcnt vmcnt(0)" ::: "memory");
    } else {
      XB_SPIN(xb_ld(&bar[XB_XGEN(b.x)]) == gen, bar);
      __builtin_amdgcn_fence(__ATOMIC_ACQUIRE, "agent");
      asm volatile("s_waitcnt vmcnt(0)" ::: "memory");
    }
  }
  __syncthreads();
}

constexpr int PH_PER_LAYER = 14;
__device__ __forceinline__ void run_phase(const Params& p, int ph, unsigned char* smem) {
  const int l = ph / PH_PER_LAYER, k = ph % PH_PER_LAYER;
  unsigned char* ws = p.ws;
  bf16_t* U = (bf16_t*)(ws + OFF_U);
  bf16_t* P = (bf16_t*)(ws + OFF_P);
  const float* xcur = (l == 0) ? p.in[I_X] : p.out;
  switch (k) {
    case 0: phase_convert(p, l, smem); break;
    case 1: phase_norm(xcur, p.in[I_F1N] + l * DM, U); break;
    case 2: phase_ffn_up_wide(U, (const bf16_t*)(ws + OFF_WGU1), P, smem); break;
    case 3: phase_gemm_resid_wide(P, DFF, (const bf16_t*)(ws + OFF_WD1), DFF, xcur, p.out, 0.5f, smem); break;
    case 4: phase_norm(p.out, p.in[I_MIXN] + l * DM, U); break;
    case 5: phase_proj(p, l, smem); break;
    case 6: {
      const int nitems = 128 + 1024 + 1024 + 1024;
      const int G = gridDim.x;
      for (int base = 0, rnd = 0; base < nitems; base += G, ++rnd) {
        const int it = base + (rnd ? (G - 1 - (int)blockIdx.x) : (int)blockIdx.x);
        if (it >= nitems) continue;
        if (it < 128) compress_gemm1_tile(p, it, smem);
        else if (it < 128 + 1024) swa_unit(p, l, it - 128, smem);
        else if (it < 128 + 1024 + 1024) ret_state_unit(p, it - 1152, smem);
        else conv_item(p, l, it - 2176);
        __syncthreads();
      }
    } break;
    case 7: compress2(p, l); ret_scan(p); break;
    case 8: {
      const int G = gridDim.x;
#ifdef DRY_M3
      { int rnd2 = 0;
        for (int base = 0; base < 1024; base += G, ++rnd2) {
          const int it = base + ((rnd2 & 1) ? (G - 1 - (int)blockIdx.x) : (int)blockIdx.x);
          if (it < 1024) nsa_unit(p, l, it, smem, C_BX);
          __syncthreads();
        }
        for (int it = blockIdx.x; it < 1024; it += gridDim.x) { ret_out_unit(p, l, it, smem, C_BC); __syncthreads(); }
      }
#endif
      int rnd = 0;
      for (int base = 0; base < 1024; base += G, ++rnd) {
        const int it = base + ((rnd & 1) ? (G - 1 - (int)blockIdx.x) : (int)blockIdx.x);
        if (it < 1024) nsa_unit(p, l, it, smem);
        __syncthreads();
      }
      for (int it = blockIdx.x; it < 1024; it += gridDim.x) {
        ret_out_unit(p, l, it, smem);
        __syncthreads();
      }
    } break;
    case 9: phase_merge(p, l, smem); break;
    case 10: phase_gemm_resid_wide(P + C_MERGED, LDP, (const bf16_t*)(ws + OFF_WOUT), DM, p.out, p.out, 1.0f, smem); break;
    case 11: phase_norm(p.out, p.in[I_F2N] + l * DM, U); break;
    case 12: phase_ffn_up_wide(U, (const bf16_t*)(ws + OFF_WGU2), P, smem); break;
    case 13: phase_gemm_resid_wide(P, DFF, (const bf16_t*)(ws + OFF_WD2), DFF, p.out, p.out, 0.5f, smem); break;
  }
}

__global__ void __launch_bounds__(NTHREADS, 2) fwd_megakernel(Params p, int ph0, int ph1) {
  __shared__ __attribute__((aligned(16))) unsigned char smem[SMEM_BYTES];
  __shared__ uint4 xb_words;
  cg::grid_group grid = cg::this_grid();
  if (TIDX == 0) xb_words = make_uint4(0u, 0u, 0u, 0u);
  __syncthreads();
  XcdBarrier xb = xcd_barrier_post((unsigned*)(p.ws + OFF_BAR), (volatile LDS_AS unsigned*)&xb_words);
  for (int ph = ph0; ph <= ph1; ++ph) {
    run_phase(p, ph, smem);
#ifdef DBL_PHASE
    if (ph == DBL_PHASE) { xcd_barrier(xb); run_phase(p, ph, smem); }
#endif
#ifdef XSYNC
    xcd_barrier(xb);
#endif
    if (ph < ph1) {
      if (ph == ph0) grid.sync();
      else xcd_barrier(xb);
    }
  }
}

extern "C" void kernel_launch(void* const* d_in, const int* in_sizes, int n_in, void* d_out, int out_size, void* d_ws, size_t ws_size,
                              hipStream_t stream) {
  static int grid_blocks = 0;
  if (!grid_blocks) {
    int dev = 0, cus = 0, per_cu = 0;
    hipGetDevice(&dev);
    hipDeviceGetAttribute(&cus, hipDeviceAttributeMultiprocessorCount, dev);
    hipOccupancyMaxActiveBlocksPerMultiprocessor(&per_cu, fwd_megakernel, NTHREADS, 0);
    if (per_cu > 2) per_cu = 2;
    grid_blocks = cus * per_cu;
  }
  if (ws_size < WS_NEED || n_in < 27 || grid_blocks <= 0) { fprintf(stderr, "bad setup ws=%zu need=%zu grid=%d\n", ws_size, (size_t)WS_NEED, grid_blocks); return; }
  Params p{};
  for (int i = 0; i < 27; ++i) p.in[i] = (const float*)d_in[i];
  p.out = (float*)d_out;
  p.ws = (unsigned char*)d_ws;
  for (int i = 0; i < 32; ++i) p.inv_freq[i] = pow(10000.0, -(double)i / 32.0);
  int ph0 = 0, ph1 = 2 * PH_PER_LAYER - 1;
  void* args[] = {&p, &ph0, &ph1};
  hipMemsetAsync((unsigned char*)d_ws + OFF_BAR, 0, 16384, stream);
  hipError_t e = hipLaunchCooperativeKernel((void*)fwd_megakernel, dim3(grid_blocks), dim3(NTHREADS), args, 0, stream);
  if (e != hipSuccess) fprintf(stderr, "cooperative launch failed: %s (grid %d)\n", hipGetErrorString(e), grid_blocks);
}
```
